# Optimizing an MI355X kernel written in HIP

```python
import jax
import jax.numpy as jnp
from jax import lax
import numpy as np

D_MODEL = 2048
BATCH = 32
SEQ = 256
DEPTH = 2
DEC_BATCH = 2
DEC_SEQ = 2048
PAST_LEN = 512

GRID_W = 64
Q_BLOCK = 128
NORM_EPS = 1e-6
NEG_BIG = -1e30
NA_HEADS = 8
NA_HD = 64
NA_W = NA_HEADS * NA_HD
NA_KR = 8
NA_KW = 16
NA_QB = 16
NA_BAND = NA_QB + NA_KW
MLA_HEADS = 8
MLA_NOPE = 64
MLA_ROPE = 32
MLA_VD = 64
MLA_QK = MLA_NOPE + MLA_ROPE
MLA_W = MLA_HEADS * MLA_VD
MLA_Q_LORA = 512
MLA_KV_LORA = 256
ROPE_BASE = 10000.0
HG_HEADS = 8
HG_DK = 64
HG_DV = 64
HG_KW = HG_HEADS * HG_DK
HG_W = HG_HEADS * HG_DV
HG_CHUNK = 32
N_BRANCH = 3
PROJ_WIDTHS = (NA_W, NA_W, NA_W, NA_W, MLA_Q_LORA, MLA_KV_LORA, MLA_ROPE, MLA_W, HG_KW, HG_KW, HG_KW, HG_W, HG_W, N_BRANCH * D_MODEL)
PROJ_TOTAL = sum(PROJ_WIDTHS)

kernel_name = 'hybrid_na_mla_hgrn2_prefix_dit_step'


def rmsnorm(x, g):
    xf = x.astype(jnp.float32)
    y = xf * lax.rsqrt(jnp.mean(xf * xf, axis=-1, keepdims=True) + NORM_EPS)
    return (y * g.astype(jnp.float32)).astype(x.dtype)


def softmax32(s):
    e = jnp.exp(s - jnp.max(s, axis=-1, keepdims=True))
    return e / jnp.sum(e, axis=-1, keepdims=True)


def split_heads(a, n):
    return a.reshape(a.shape[:-1] + (n, a.shape[-1] // n))


def split_cols(z):
    idx = np.cumsum(PROJ_WIDTHS)[:-1].tolist()
    return jnp.split(z, idx, axis=-1)


def rope_2d(x):
    n = x.shape[1]
    t = jnp.arange(n)
    pos = jnp.stack([t // GRID_W, t % GRID_W]).astype(jnp.float32)
    axis_dim = x.shape[-1] // 2
    inv = ROPE_BASE ** (-jnp.arange(0, axis_dim, 2, dtype=jnp.float32) / axis_dim)
    ang = pos[:, :, None] * inv
    ang = jnp.concatenate([ang, ang], axis=-1)
    ang = jnp.concatenate([ang[0], ang[1]], axis=-1)
    bshape = (1, n) + (1,) * (x.ndim - 3) + (x.shape[-1],)
    cos = jnp.cos(ang).reshape(bshape)
    sin = jnp.sin(ang).reshape(bshape)
    xf = x.astype(jnp.float32)
    xs = xf.reshape(x.shape[:-1] + (2, 2, axis_dim // 2))
    rot = jnp.stack([-xs[..., 1, :], xs[..., 0, :]], axis=-2).reshape(x.shape)
    return (xf * cos + rot * sin).astype(x.dtype)


def attend_blocked(q, k, v, scale):
    B, nq, H, dq = q.shape
    qb = q.reshape(B, nq // Q_BLOCK, Q_BLOCK, H, dq).swapaxes(0, 1)

    def one(qblk):
        s = jnp.einsum('bqhd,bkhd->bhqk', qblk, k, preferred_element_type=jnp.float32) * scale
        p = softmax32(s).astype(v.dtype)
        return jnp.einsum('bhqk,bkhd->bqhd', p, v)

    o = lax.map(one, qb)
    return o.swapaxes(0, 1).reshape(B, nq, H, v.shape[-1])


def neighborhood_attention(q, k, v, k_ctx, v_ctx, rpb):
    B, N, H, Dh = q.shape
    rows = N // GRID_W
    kr = min(NA_KR, rows)
    n_qb = GRID_W // NA_QB
    r = jnp.arange(rows)
    key_rows = jnp.clip(r - NA_KR // 2, 0, rows - kr)[:, None] + jnp.arange(kr)
    qcol = jnp.arange(GRID_W).reshape(n_qb, NA_QB)
    band_cols = jnp.clip(qcol[:, 0] - NA_KW // 2, 0, GRID_W - NA_BAND)[:, None] + jnp.arange(NA_BAND)
    win0 = jnp.clip(qcol - NA_KW // 2, 0, GRID_W - NA_KW)
    bc = band_cols[:, None, :]
    col_ok = (bc >= win0[..., None]) & (bc < win0[..., None] + NA_KW)
    rel_r = key_rows - r[:, None] + NA_KR - 1
    rel_c = jnp.clip(bc - qcol[:, :, None], 1 - NA_KW, NA_KW - 1) + NA_KW - 1
    bias = rpb.astype(jnp.float32)[:, rel_r][:, :, :, rel_c]
    bias = bias.transpose(1, 3, 0, 4, 2, 5)
    bias = jnp.where(col_ok[None, :, None, :, None, :], bias, NEG_BIG)
    qg = q.reshape(B, rows, n_qb, NA_QB, H, Dh)
    kg = k.reshape(B, rows, GRID_W, H, Dh)[:, key_rows][:, :, :, band_cols]
    vg = v.reshape(B, rows, GRID_W, H, Dh)[:, key_rows][:, :, :, band_cols]
    scale = Dh ** -0.5
    s_loc = jnp.einsum('brpihd,brkpjhd->brphikj', qg, kg, preferred_element_type=jnp.float32) * scale + bias
    s_ctx = jnp.einsum('brpihd,bchd->brphic', qg, k_ctx, preferred_element_type=jnp.float32) * scale
    n_loc = kr * NA_BAND
    s = jnp.concatenate([s_loc.reshape(s_loc.shape[:5] + (n_loc,)), s_ctx], axis=-1)
    p = softmax32(s).astype(v.dtype)
    p_loc = p[..., :n_loc].reshape(s_loc.shape)
    o = (jnp.einsum('brphikj,brkpjhd->brpihd', p_loc, vg)
         + jnp.einsum('brphic,bchd->brpihd', p[..., n_loc:], v_ctx))
    return o.reshape(B, N, H * Dh)


def mla_kv(ckv_n, k_rope, w_ukv):
    B, N, _ = ckv_n.shape
    kv = (ckv_n @ w_ukv).reshape(B, N, MLA_HEADS, MLA_NOPE + MLA_VD)
    kr = jnp.broadcast_to(k_rope[:, :, None, :], (B, N, MLA_HEADS, MLA_ROPE))
    return jnp.concatenate([kv[..., :MLA_NOPE], kr], axis=-1), kv[..., MLA_NOPE:]


def lower_bounds(p):
    s = jax.nn.softmax(p.astype(jnp.float32), axis=0)
    return jnp.cumsum(s, axis=0) - s[0]


def hgrn_gates(z, lb):
    zf = z.astype(jnp.float32)
    pos = lb > 0
    log_lb = jnp.where(pos, jnp.log(jnp.where(pos, lb, 1.0)), NEG_BIG)
    logf = jnp.logaddexp(log_lb, jnp.log1p(-lb) + jax.nn.log_sigmoid(zf))
    return split_heads(logf, HG_HEADS), split_heads(-jnp.expm1(logf), HG_HEADS)


def hgrn_chunk_scan(q, k, v, logf, s0):
    B, N, H, _ = q.shape
    nc = N // HG_CHUNK

    def chunks(a):
        return a.reshape(B, nc, HG_CHUNK, H, a.shape[-1]).transpose(1, 0, 3, 2, 4)

    causal = jnp.tril(jnp.ones((HG_CHUNK, HG_CHUNK), dtype=bool))[:, :, None]

    def step(S, xs):
        qc, kc, vc, gc = xs
        b = jnp.cumsum(gc, axis=2)
        diff = b[:, :, :, None, :] - b[:, :, None, :, :]
        decay = jnp.where(causal, jnp.exp(jnp.minimum(diff, 0.0)), 0.0)
        attn = jnp.einsum('bhtk,bhsk,bhtsk->bhts', qc, kc, decay)
        o = jnp.einsum('bhts,bhsv->bhtv', attn, vc) + jnp.einsum('bhtk,bhkv->bhtv', qc * jnp.exp(b), S)
        b_end = b[:, :, -1:, :]
        S = jnp.exp(b_end[:, :, 0, :, None]) * S + jnp.einsum('bhsk,bhsv->bhkv', kc * jnp.exp(b_end - b), vc)
        return S, o

    s_fin, o = lax.scan(step, s0, (chunks(q), chunks(k), chunks(v), chunks(logf)))
    return o.transpose(1, 0, 3, 2, 4).reshape(B, N, H, v.shape[-1]), s_fin


def mixer(h, lp, ctx):
    B, N, _ = h.shape
    (na_q, na_k, na_v, na_g, mla_cq, mla_ckv, mla_kr, mla_g,
     hg_q, hg_ff, hg_fb, hg_i, hg_g, mg) = split_cols(h @ lp['w_in'])
    qa, ka, va = split_heads(na_q, NA_HEADS), split_heads(na_k, NA_HEADS), split_heads(na_v, NA_HEADS)
    if ctx is None:
        o_na = attend_blocked(qa, ka, va, NA_HD ** -0.5).reshape(B, N, NA_W)
    else:
        o_na = neighborhood_attention(qa, ka, va, ctx[0], ctx[1], lp['na_rpb'])
    ckv_n = rmsnorm(mla_ckv, lp['g_mla_kv'])
    qb = split_heads(rmsnorm(mla_cq, lp['g_mla_q']) @ lp['w_mla_uq'], MLA_HEADS)
    if ctx is None:
        kb, vb = mla_kv(ckv_n, mla_kr, lp['w_mla_ukv'])
    else:
        qb = jnp.concatenate([qb[..., :MLA_NOPE], rope_2d(qb[..., MLA_NOPE:])], axis=-1)
        kb, vb = mla_kv(jnp.concatenate([ctx[2], ckv_n], axis=1),
                        jnp.concatenate([ctx[3], rope_2d(mla_kr)], axis=1), lp['w_mla_ukv'])
    o_mla = attend_blocked(qb, kb, vb, MLA_QK ** -0.5).reshape(B, N, MLA_W)
    qh = split_heads(jax.nn.silu(hg_q.astype(jnp.float32)), HG_HEADS)
    vh = split_heads(hg_i.astype(jnp.float32), HG_HEADS)
    lf_f, k_f = hgrn_gates(hg_ff, lp['lb_fwd'])
    lf_b, k_b = hgrn_gates(hg_fb, lp['lb_bwd'])
    if ctx is None:
        s0_f = jnp.zeros((B, HG_HEADS, HG_DK, HG_DV), jnp.float32)
        s0_b = s0_f
    else:
        s0_f, s0_b = ctx[4].astype(jnp.float32), ctx[5].astype(jnp.float32)
    o_f, s_f = hgrn_chunk_scan(qh, k_f, vh, lf_f, s0_f)
    o_b, s_b = hgrn_chunk_scan(jnp.flip(qh, 1), jnp.flip(k_b, 1), jnp.flip(vh, 1), jnp.flip(lf_b, 1), s0_b)
    o_hg = rmsnorm(o_f + jnp.flip(o_b, 1), lp['g_hg_out'].reshape(HG_HEADS, HG_DV))
    o_hg = o_hg.reshape(B, N, HG_W).astype(h.dtype)
    mg_na, mg_mla, mg_hg = jnp.split(mg, N_BRANCH, axis=-1)
    merged = (jax.nn.sigmoid(mg_na) * ((o_na * jax.nn.silu(na_g)) @ lp['w_br_na'])
              + jax.nn.sigmoid(mg_mla) * ((o_mla * jax.nn.silu(mla_g)) @ lp['w_br_mla'])
              + jax.nn.sigmoid(mg_hg) * ((o_hg * jax.nn.silu(hg_g)) @ lp['w_br_hg']))
    out = merged @ lp['w_out']
    new_ctx = (ka, va, ckv_n, mla_kr, s_f, s_b) if ctx is None else None
    return out, new_ctx


def layer(x, mod, lp, ctx):
    shift, scale, gate = jnp.split(mod, 3, axis=-1)
    h = rmsnorm(x, lp['g_pre']) * (1 + scale) + shift
    out, new_ctx = mixer(h, lp, ctx)
    return x + gate * rmsnorm(out, lp['g_post']), new_ctx


def setup_inputs(seed: int = 0) -> dict:
    key = jax.random.key(seed)
    ks = jax.random.split(key, 32)

    def nrm(k, shape, s=1.0):
        return jax.random.normal(k, shape, jnp.float32) * s

    def gain(k, shape):
        return 1.0 + nrm(k, shape, 0.02)

    return {
        'x_prompt': nrm(ks[0], (BATCH, SEQ, D_MODEL)),
        'x_sample': nrm(ks[1], (DEC_BATCH, DEC_SEQ, D_MODEL)),
        'cache_na_k': nrm(ks[2], (DEC_BATCH, DEPTH, PAST_LEN, NA_HEADS, NA_HD)),
        'cache_na_v': nrm(ks[3], (DEC_BATCH, DEPTH, PAST_LEN, NA_HEADS, NA_HD)),
        'cache_mla_ckv': nrm(ks[4], (DEC_BATCH, DEPTH, PAST_LEN, MLA_KV_LORA)),
        'cache_mla_krope': nrm(ks[5], (DEC_BATCH, DEPTH, PAST_LEN, MLA_ROPE)),
        'state_hgrn_fwd': nrm(ks[6], (DEC_BATCH, DEPTH, HG_HEADS, HG_DK, HG_DV), 0.5),
        'state_hgrn_bwd': nrm(ks[7], (DEC_BATCH, DEPTH, HG_HEADS, HG_DK, HG_DV), 0.5),
        'c': nrm(ks[8], (DEC_BATCH, D_MODEL)),
        'c_ctx': nrm(ks[9], (D_MODEL,)),
        'w_ada': nrm(ks[10], (DEPTH, D_MODEL, 3 * D_MODEL), D_MODEL ** -0.5),
        'b_ada': nrm(ks[11], (DEPTH, 3 * D_MODEL), 0.02),
        'g_pre': gain(ks[12], (DEPTH, D_MODEL)),
        'g_post': gain(ks[13], (DEPTH, D_MODEL)),
        'w_in': nrm(ks[14], (DEPTH, D_MODEL, PROJ_TOTAL), D_MODEL ** -0.5),
        'na_rpb': nrm(ks[15], (DEPTH, NA_HEADS, 2 * NA_KR - 1, 2 * NA_KW - 1), 0.1),
        'g_mla_q': gain(ks[16], (DEPTH, MLA_Q_LORA)),
        'w_mla_uq': nrm(ks[17], (DEPTH, MLA_Q_LORA, MLA_HEADS * MLA_QK), MLA_Q_LORA ** -0.5),
        'g_mla_kv': gain(ks[18], (DEPTH, MLA_KV_LORA)),
        'w_mla_ukv': nrm(ks[19], (DEPTH, MLA_KV_LORA, MLA_HEADS * (MLA_NOPE + MLA_VD)), MLA_KV_LORA ** -0.5),
        'hg_lb_fwd': nrm(ks[20], (DEPTH, HG_KW)),
        'hg_lb_bwd': nrm(ks[21], (DEPTH, HG_KW)),
        'g_hg_out': gain(ks[22], (DEPTH, HG_W)),
        'w_br_na': nrm(ks[23], (DEPTH, NA_W, D_MODEL), NA_W ** -0.5),
        'w_br_mla': nrm(ks[24], (DEPTH, MLA_W, D_MODEL), MLA_W ** -0.5),
        'w_br_hg': nrm(ks[25], (DEPTH, HG_W, D_MODEL), HG_W ** -0.5),
        'w_out': nrm(ks[26], (DEPTH, D_MODEL, D_MODEL), D_MODEL ** -0.5),
    }


def reference(x_prompt, x_sample, cache_na_k, cache_na_v, cache_mla_ckv, cache_mla_krope,
              state_hgrn_fwd, state_hgrn_bwd, c, c_ctx, w_ada, b_ada, g_pre, g_post, w_in, na_rpb,
              g_mla_q, w_mla_uq, g_mla_kv, w_mla_ukv, hg_lb_fwd, hg_lb_bwd, g_hg_out,
              w_br_na, w_br_mla, w_br_hg, w_out):
    lb_f_all = lower_bounds(hg_lb_fwd)
    lb_b_all = lower_bounds(hg_lb_bwd)
    y_prompt, y_sample = x_prompt, x_sample
    ctx_out = []
    for l in range(DEPTH):
        lp = {'g_pre': g_pre[l], 'g_post': g_post[l], 'w_in': w_in[l], 'na_rpb': na_rpb[l],
              'g_mla_q': g_mla_q[l], 'w_mla_uq': w_mla_uq[l], 'g_mla_kv': g_mla_kv[l], 'w_mla_ukv': w_mla_ukv[l],
              'lb_fwd': lb_f_all[l], 'lb_bwd': lb_b_all[l], 'g_hg_out': g_hg_out[l],
              'w_br_na': w_br_na[l], 'w_br_mla': w_br_mla[l], 'w_br_hg': w_br_hg[l], 'w_out': w_out[l]}
        mod_ctx = (jax.nn.silu(c_ctx) @ w_ada[l] + b_ada[l])[None, None, :]
        mod_lat = (jax.nn.silu(c) @ w_ada[l] + b_ada[l])[:, None, :]
        y_prompt, ctx_l = layer(y_prompt, mod_ctx, lp, None)
        ctx_out.append(ctx_l)
        cached = (cache_na_k[:, l], cache_na_v[:, l], cache_mla_ckv[:, l], cache_mla_krope[:, l],
                  state_hgrn_fwd[:, l], state_hgrn_bwd[:, l])
        y_sample, _ = layer(y_sample, mod_lat, lp, cached)
    new_na_k = jnp.stack([t[0] for t in ctx_out], axis=1)
    new_na_v = jnp.stack([t[1] for t in ctx_out], axis=1)
    new_mla_ckv = jnp.stack([t[2] for t in ctx_out], axis=1)
    new_mla_krope = jnp.stack([t[3] for t in ctx_out], axis=1)
    new_state_fwd = jnp.stack([t[4] for t in ctx_out], axis=1)
    new_state_bwd = jnp.stack([t[5] for t in ctx_out], axis=1)
    return (y_prompt, y_sample, new_na_k, new_na_v, new_mla_ckv, new_mla_krope, new_state_fwd, new_state_bwd)
```

```cpp
#include <hip/hip_runtime.h>
#include <hip/hip_cooperative_groups.h>
#include <cstdio>
#include <cstdint>
namespace cg = cooperative_groups;
#ifndef REP_L1
#define REP_L1 1
#endif
#ifndef REP_L2
#define REP_L2 1
#endif
#ifndef REP_L3
#define REP_L3 1
#endif
#ifndef REP_L4
#define REP_L4 1
#endif
#ifndef REP_L5
#define REP_L5 1
#endif
#ifndef REP_NAP
#define REP_NAP 1
#endif
#ifndef REP_NAS
#define REP_NAS 1
#endif
#ifndef REP_H1
#define REP_H1 1
#endif
#ifndef REP_MLAP
#define REP_MLAP 1
#endif
#ifndef REP_MLAS
#define REP_MLAS 1
#endif
#ifndef REP_H2
#define REP_H2 1
#endif
#ifndef REP_S0
#define REP_S0 1
#endif

#define DI __device__ __forceinline__
#define OPAQUE_V(x) asm volatile("" : "+v"(x))
#define OPAQUE_S(x) asm volatile("" : "+s"(x))
__device__ __forceinline__ int opq_s(int x) { asm volatile("" : "+s"(x)); return x; }
__device__ __forceinline__ int lane_id() { int l; asm volatile("v_mbcnt_lo_u32_b32 %0, -1, 0\n\tv_mbcnt_hi_u32_b32 %0, -1, %0" : "=v"(l)); return l; }
#define LAS __attribute__((address_space(3)))
typedef unsigned short bf16_t;
typedef short bf16x8 __attribute__((ext_vector_type(8)));
typedef short s16x4 __attribute__((ext_vector_type(4)));
typedef float f32x4 __attribute__((ext_vector_type(4)));
typedef float f32x2 __attribute__((ext_vector_type(2)));
typedef float f32x16 __attribute__((ext_vector_type(16)));
typedef unsigned u32x4 __attribute__((ext_vector_type(4)));
typedef unsigned u32x2 __attribute__((ext_vector_type(2)));
typedef __bf16 bf16v2 __attribute__((ext_vector_type(2)));

DI unsigned pk2(float a, float b) { bf16v2 v = __builtin_convertvector((f32x2){a, b}, bf16v2); return __builtin_bit_cast(unsigned, v); }
DI bf16_t f2bf(float a) { return (bf16_t)(pk2(a, 0.f) & 0xffffu); }
DI float bf2f(unsigned u16) { return __uint_as_float(u16 << 16); }
DI float bflo(unsigned w) { return __uint_as_float(w << 16); }
DI float bfhi(unsigned w) { return __uint_as_float(w & 0xffff0000u); }
DI float sigmoidf_(float x) { return __builtin_amdgcn_rcpf(1.f + __expf(-x)); }
DI float siluf_(float x) { return x * sigmoidf_(x); }
template <int XM> DI float xor_swz(float x) { return __int_as_float(__builtin_amdgcn_ds_swizzle(__float_as_int(x), (XM << 10) | 0x1f)); }
DI float max_x32(float x) { const auto r = __builtin_amdgcn_permlane32_swap(__float_as_uint(x), __float_as_uint(x), false, false); return fmaxf(__uint_as_float(r[0]), __uint_as_float(r[1])); }
DI float sum_x32(float x) { const auto r = __builtin_amdgcn_permlane32_swap(__float_as_uint(x), __float_as_uint(x), false, false); return __uint_as_float(r[0]) + __uint_as_float(r[1]); }
DI float wave_sum(float v) {
    v += xor_swz<1>(v); v += xor_swz<2>(v); v += xor_swz<4>(v); v += xor_swz<8>(v); v += xor_swz<16>(v); v = sum_x32(v);
    return v;
}

constexpr int DM = 2048, NTOK = 12288, NPR = 8192, NSM = 4096, PSEQ = 256, SSEQ = 2048, PAST = 512, NPROJ = 12288, PROJ_ORIG = 12064;
constexpr float EPS = 1e-6f, LOG2E = 1.4426950408889634f;
constexpr float QS_NA = 0.125f * LOG2E;
constexpr float QS_MLA = 0.10206207261596575f * LOG2E;
constexpr float NEG = -1e30f;
constexpr float DEFER_THR = 8.f;

constexpr size_t al256(size_t x) { return (x + 255) & ~(size_t)255; }
constexpr size_t O_WIN = 0;
constexpr size_t O_WOUT = O_WIN + al256((size_t)2 * NPROJ * DM * 2);
constexpr size_t O_WBR = O_WOUT + al256((size_t)2 * DM * DM * 2);
constexpr size_t O_WUQ = O_WBR + al256((size_t)2 * 3 * DM * 512 * 2);
constexpr size_t O_WUKV = O_WUQ + al256((size_t)2 * 768 * 512 * 2);
constexpr size_t O_WUKVG = O_WUKV + al256((size_t)2 * 1024 * 256 * 2);
constexpr size_t O_MOD = O_WUKVG + al256((size_t)2 * 1024 * 256 * 2);
constexpr size_t O_ROPE = O_MOD + al256((size_t)2 * 3 * 6144 * 4);
constexpr size_t O_CKA = O_ROPE + al256((size_t)64 * 8 * 2 * 4);
constexpr size_t O_CVTA = O_CKA + al256((size_t)2 * 2 * 512 * 512 * 2);
constexpr size_t O_CCKV = O_CVTA + al256((size_t)2 * 2 * 512 * 512 * 2);
constexpr size_t O_KNS = O_CCKV + al256((size_t)2 * 2 * 512 * 256 * 2);
constexpr size_t O_KRS = O_KNS + al256((size_t)2 * 2 * 2560 * 512 * 2);
constexpr size_t O_VTMS = O_KRS + al256((size_t)2 * 2 * 2560 * 32 * 2);
constexpr size_t O_H = O_VTMS + al256((size_t)2 * 2 * 8 * 64 * 2560 * 2);
constexpr size_t O_QA = O_H + al256((size_t)NTOK * DM * 2);
constexpr size_t O_KA = O_QA + al256((size_t)NTOK * 512 * 2);
constexpr size_t O_VTA = O_KA + al256((size_t)NTOK * 512 * 2);
constexpr size_t O_GNA = O_VTA + al256((size_t)NTOK * 512 * 2);
constexpr size_t O_CQ = O_GNA + al256((size_t)NTOK * 512 * 2);
constexpr size_t O_CQSS = O_CQ + al256((size_t)NTOK * 512 * 2);
constexpr size_t O_CKVB = O_CQSS + al256((size_t)NTOK * 8 * 4);
constexpr size_t O_CKVF = O_CKVB + al256((size_t)NTOK * 256 * 2);
constexpr size_t O_CKVSS = O_CKVF + al256((size_t)NPR * 256 * 4);
constexpr size_t O_GMLA = O_CKVSS + al256((size_t)NTOK * 4 * 4);
constexpr size_t O_HQ = O_GMLA + al256((size_t)NTOK * 512 * 2);
constexpr size_t O_LFF = O_HQ + (size_t)NTOK * 512 * 4;
constexpr size_t O_LFB = O_LFF + (size_t)NTOK * 512 * 4;
constexpr size_t O_HV = O_LFB + (size_t)NTOK * 512 * 4;
constexpr size_t O_GHG = O_HV + (size_t)NTOK * 512 * 4;
constexpr size_t O_SIG = O_GHG + al256((size_t)NTOK * 512 * 2);
constexpr size_t O_KRF = O_SIG + al256((size_t)NTOK * 6144 * 2);
constexpr size_t O_QM = O_KRF + al256((size_t)NTOK * 32 * 4);
constexpr size_t O_KNP = O_QM + al256((size_t)NTOK * 768 * 2);
constexpr size_t O_KRP = O_KNP + al256((size_t)NPR * 512 * 2);
constexpr size_t O_VTMP = O_KRP + al256((size_t)NPR * 32 * 2);
constexpr size_t O_OBR = O_VTMP + al256((size_t)NPR * 512 * 2);
constexpr size_t O_OPART = O_OBR + al256((size_t)3 * NTOK * 512 * 2);
constexpr size_t O_SGRP = O_OPART + al256((size_t)2 * NTOK * 512 * 4);
constexpr size_t O_DGRP = O_SGRP + al256((size_t)1536 * 4096 * 4);
constexpr size_t O_OSS = O_DGRP + al256((size_t)1536 * 64 * 4);
constexpr size_t O_OTMP = O_OSS + al256((size_t)NTOK * 32 * 4);
constexpr size_t O_GST = O_OTMP + al256((size_t)NTOK * 512 * 4);
constexpr size_t WS_END = O_GST + al256((size_t)512 * 4096 * 4);
constexpr size_t O_CTL = WS_END, O_CNT = O_CTL + 16384, CTL_BYTES = 16384 + 96 * 256;
constexpr size_t WS_TOTAL = O_CTL + CTL_BYTES;
static_assert(WS_TOTAL < (size_t)780 * 1024 * 1024, "workspace map too large");
constexpr size_t O_PMRG = O_HQ, O_MERGED = O_H, O_OUTB = O_HQ;
constexpr size_t O_QE = O_H;
static_assert((size_t)2 * NTOK * 512 * 4 <= (size_t)NTOK * DM * 2, "QE overlay");

constexpr size_t OUT_YP = 0, OUT_YS = OUT_YP + (size_t)NPR * DM, OUT_NK = OUT_YS + (size_t)NSM * DM, OUT_NV = OUT_NK + (size_t)32 * 2 * 256 * 512,
                 OUT_CKV = OUT_NV + (size_t)32 * 2 * 256 * 512, OUT_KR = OUT_CKV + (size_t)32 * 2 * 256 * 256, OUT_SF = OUT_KR + (size_t)32 * 2 * 256 * 32,
                 OUT_SB = OUT_SF + (size_t)32 * 2 * 8 * 4096, OUT_END = OUT_SB + (size_t)32 * 2 * 8 * 4096;

struct Params {
    const float* in[27];
    float* out;
    unsigned char* ws;
};
enum { I_XP = 0, I_XS, I_CNK, I_CNV, I_CCKV, I_CKR, I_SF, I_SB, I_C, I_CCTX, I_WADA, I_BADA, I_GPRE, I_GPOST, I_WIN, I_RPB, I_GMQ, I_WUQ, I_GMKV, I_WUKV,
       I_LBF, I_LBB, I_GHG, I_WBNA, I_WBMLA, I_WBHG, I_WOUT };

namespace pg8 {
#define PG8_LAS __attribute__((address_space(3)))
constexpr int BM = 256, BK = 64, HALF = 128, HTB = HALF * BK * 2, STAGE_BYTES = 8 * HTB, NXCD = 8, WGM = 8;
__host__ __device__ __forceinline__ int lds_byte(int r, int c) { const int st = (r >> 4) * 2 + (c >> 5), rr = r & 15, cc = c & 31, ob = rr * 64 + cc * 2; return st * 1024 + (ob ^ (((ob >> 9) & 1) << 5)); }
__host__ __device__ __forceinline__ void stage_rc(int b, int& R, int& C) { const int st = b / 1024, sb = b % 1024, swz = sb ^ (((sb >> 9) & 1) << 5); R = (st >> 1) * 16 + swz / 64; C = (st & 1) * 32 + (swz % 64) / 2; }
__host__ __device__ __forceinline__ int perm32(int rho) { const int n = rho >> 4, i = rho & 15; return 8 * (i >> 2) + 4 * n + (i & 3); }
struct Unit { int pm, pn, br; };
struct Gemm { const bf16_t* A; const bf16_t* Bt; int M, N, K; size_t a_br, b_br; };
struct StaticOrder {
    int nM, nN, nwg, G, c, nbr;
    __device__ void init(int M, int N, int G_, int c_, int nbr_) { nM = M / BM; nN = N / BM; nwg = nM * nN; G = G_; c = c_; nbr = nbr_; }
    __device__ bool next(int i, Unit& u) const {
        const int it = i / nbr; u.br = i - it * nbr;
        const long L = (long)it * G + c; if (L >= nwg) return false;
        int wgid = (int)L; { const int q = nwg / NXCD, r = nwg % NXCD, xcd = wgid % NXCD, off = wgid / NXCD; wgid = (xcd < r ? xcd * (q + 1) : r * (q + 1) + (xcd - r) * q) + off; }
        const int nig = WGM * nN, gid = wgid / nig, fm = gid * WGM, gsz = (nM - fm) < WGM ? (nM - fm) : WGM;
        u.pm = fm + ((wgid % nig) % gsz); u.pn = (wgid % nig) / gsz; return true;
    }
    __device__ __forceinline__ void a_ready(const Unit&) const {}
    __device__ __forceinline__ void done(const Unit&) const {}
};
struct CountedOrder : StaticOrder {
    const unsigned* ready; unsigned need; int pm0, wid;
    __device__ __forceinline__ void a_ready(const Unit& u) const {
        if (wid == 0) {
            const unsigned* p = ready + 64 * (pm0 + u.pm); unsigned polls = 0;
            while ((unsigned)__builtin_amdgcn_readfirstlane(__hip_atomic_load(p, __ATOMIC_RELAXED, __HIP_MEMORY_SCOPE_AGENT)) < need) { __builtin_amdgcn_s_sleep(2); if (++polls > (1u << 22)) break; }
            __builtin_amdgcn_fence(__ATOMIC_ACQUIRE, "agent");
            asm volatile("s_waitcnt vmcnt(0)" ::: "memory");
        }
        asm volatile("" ::: "memory"); __builtin_amdgcn_s_barrier(); asm volatile("" ::: "memory");
    }
};
template <class Epi, class Sched>
__device__ __forceinline__ void gemm_phase(PG8_LAS unsigned char* lds, const Gemm g, const Sched& S, const Epi& E, const int wid_in) {
    const int wid = wid_in, lane = lane_id(), tid = wid * 64 + lane, wr = wid >> 2, wc = wid & 3, fr = lane & 15, fq = lane >> 4;
    const int K = g.K, nt = K / BK;
    unsigned voffA[2], voffB[2];
#pragma unroll
    for (int i = 0; i < 2; ++i) { int R, C; stage_rc(tid * 16 + i * 8192, R, C); const int Rb = Epi::PERM ? ((R & ~31) + perm32(R & 31)) : R;
        voffA[i] = (unsigned)(R * K + C) * 2u; voffB[i] = (unsigned)(Rb * K + C) * 2u; }
    const size_t kstep = (size_t)(BK * 2);
    const size_t hstep = (size_t)HALF * K * 2;
    const size_t tstep = 2 * hstep;
    const unsigned ldsw = (unsigned)wid * 1024u;
    const int aoff = lds_byte(wr * 64 + fr, fq * 8), boff = lds_byte(wc * 32 + fr, fq * 8);
#define PG8_SA(b, h) (((b) * 2 + (h)) * HTB)
#define PG8_SB(b, h) ((4 + (b) * 2 + (h)) * HTB)
#define PG8_STAGE(bufoff, gbase, voff) do { _Pragma("unroll") for (int _i = 0; _i < 2; ++_i) \
        __builtin_amdgcn_global_load_lds((const unsigned*)((const char*)(gbase) + (voff)[_i]), (PG8_LAS unsigned*)(lds + (bufoff) + ldsw + _i * 8192), 16, 0, 0); } while (0)
#define PG8_LDA(dst, b, h) do { _Pragma("unroll") for (int m = 0; m < 4; ++m) _Pragma("unroll") for (int k = 0; k < 2; ++k) dst[m][k] = *(const PG8_LAS bf16x8*)(lds + PG8_SA(b, h) + aoff + m * 2048 + k * 1024); } while (0)
#define PG8_LDB(dst, b, h) do { _Pragma("unroll") for (int n = 0; n < 2; ++n) _Pragma("unroll") for (int k = 0; k < 2; ++k) dst[n][k] = *(const PG8_LAS bf16x8*)(lds + PG8_SB(b, h) + boff + n * 2048 + k * 1024); } while (0)
#define PG8_MMA(ai, bj, At, Bt) do { __builtin_amdgcn_s_setprio(1); _Pragma("unroll") for (int m = 0; m < 4; ++m) _Pragma("unroll") for (int n = 0; n < 2; ++n) _Pragma("unroll") for (int k = 0; k < 2; ++k) \
        acc[ai][bj][m][n] = __builtin_amdgcn_mfma_f32_16x16x32_bf16(Bt[n][k], At[m][k], acc[ai][bj][m][n], 0, 0, 0); __builtin_amdgcn_s_setprio(0); } while (0)
#define PG8_WAIT_V(n) asm volatile("s_waitcnt vmcnt(" #n ")" ::: "memory")
#define PG8_WAIT_L(n) asm volatile("s_waitcnt lgkmcnt(" #n ")" ::: "memory")
#define PG8_BAR __builtin_amdgcn_s_barrier()
#define PG8_SCHED __builtin_amdgcn_sched_barrier(0)
    Unit cur, nxt; int ui = 0;
    if (!S.next(0, cur)) return;
    f32x4 acc[2][2][4][2];
#pragma unroll
    for (int a = 0; a < 2; ++a)
#pragma unroll
        for (int b = 0; b < 2; ++b)
#pragma unroll
            for (int m = 0; m < 4; ++m)
#pragma unroll
                for (int n = 0; n < 2; ++n) acc[a][b][m][n] = (f32x4){0.f, 0.f, 0.f, 0.f};
    bf16x8 At[4][2], B0[2][2], B1[2][2];
    const char* cA = (const char*)g.A + (size_t)cur.pm * tstep + (size_t)cur.br * g.a_br; const char* cB = (const char*)g.Bt + (size_t)cur.pn * tstep + (size_t)cur.br * g.b_br;
    S.a_ready(cur);
    PG8_STAGE(PG8_SB(0, 0), cB, voffB); PG8_STAGE(PG8_SA(0, 0), cA, voffA); PG8_STAGE(PG8_SB(0, 1), cB + hstep, voffB); PG8_STAGE(PG8_SA(0, 1), cA + hstep, voffA);
    if (wr == 1) PG8_BAR;
    PG8_WAIT_V(4); PG8_BAR;
    PG8_STAGE(PG8_SB(1, 0), cB + kstep, voffB); PG8_STAGE(PG8_SA(1, 0), cA + kstep, voffA); PG8_STAGE(PG8_SB(1, 1), cB + hstep + kstep, voffB);
    PG8_WAIT_V(6); PG8_BAR;
    for (;;) {
        const bool has_next = S.next(ui + 1, nxt);
        const char* nA = has_next ? (const char*)g.A + (size_t)nxt.pm * tstep + (size_t)nxt.br * g.a_br : cA; const char* nB = has_next ? (const char*)g.Bt + (size_t)nxt.pn * tstep + (size_t)nxt.br * g.b_br : cB;
        for (int t = 0; t < nt; t += 2) {
            const bool last = (t == nt - 2);
            const char* a1 = cA + (size_t)(t + 1) * kstep;
            const char* a2 = last ? nA : cA + (size_t)(t + 2) * kstep; const char* b2 = last ? nB : cB + (size_t)(t + 2) * kstep;
            const char* a3 = a2 + kstep; const char* b3 = b2 + kstep;
            if (last && has_next) S.a_ready(nxt);
            PG8_LDB(B0, 0, 0); PG8_SCHED; PG8_LDA(At, 0, 0); PG8_STAGE(PG8_SA(1, 1), a1 + hstep, voffA);
            PG8_WAIT_L(8); PG8_BAR; PG8_WAIT_L(0); PG8_MMA(0, 0, At, B0); PG8_BAR; PG8_SCHED;
            PG8_LDB(B1, 0, 1); PG8_STAGE(PG8_SB(0, 0), b2, voffB);
            PG8_BAR; PG8_WAIT_L(0); PG8_MMA(0, 1, At, B1); PG8_BAR;
            PG8_LDA(At, 0, 1); PG8_STAGE(PG8_SA(0, 0), a2, voffA);
            PG8_BAR; PG8_WAIT_L(0); PG8_MMA(1, 0, At, B0); PG8_BAR; PG8_SCHED;
            PG8_STAGE(PG8_SB(0, 1), b2 + hstep, voffB);
            PG8_WAIT_V(6); PG8_BAR; PG8_MMA(1, 1, At, B1); PG8_BAR;
            PG8_LDB(B0, 1, 0); PG8_SCHED; PG8_LDA(At, 1, 0); PG8_STAGE(PG8_SA(0, 1), a2 + hstep, voffA);
            PG8_WAIT_L(8); PG8_BAR; PG8_WAIT_L(0); PG8_MMA(0, 0, At, B0); PG8_BAR; PG8_SCHED;
            PG8_LDB(B1, 1, 1); PG8_STAGE(PG8_SB(1, 0), b3, voffB);
            PG8_BAR; PG8_WAIT_L(0); PG8_MMA(0, 1, At, B1); PG8_BAR;
            PG8_LDA(At, 1, 1); PG8_STAGE(PG8_SA(1, 0), a3, voffA);
            PG8_BAR; PG8_WAIT_L(0); PG8_MMA(1, 0, At, B0); PG8_BAR; PG8_SCHED;
            PG8_STAGE(PG8_SB(1, 1), b3 + hstep, voffB);
            PG8_WAIT_V(6); PG8_BAR; PG8_MMA(1, 1, At, B1); PG8_BAR;
        }
        if constexpr (!Epi::AFTER_DRAIN) { E(acc, cur, wr, wc, fr, fq); S.done(cur); }
        if (!has_next) break;
        if constexpr (!Epi::KEEP_ACC)
#pragma unroll
        for (int a = 0; a < 2; ++a)
#pragma unroll
            for (int b = 0; b < 2; ++b)
#pragma unroll
                for (int m = 0; m < 4; ++m)
#pragma unroll
                    for (int n = 0; n < 2; ++n) acc[a][b][m][n] = (f32x4){0.f, 0.f, 0.f, 0.f};
        cur = nxt; cA = nA; cB = nB; ++ui;
    }
    PG8_WAIT_V(0);
    if (wr == 0) PG8_BAR;
    PG8_BAR;
    if constexpr (Epi::AFTER_DRAIN) { E.fused(acc, cur, wr, wc, fr, fq, lds, wid, lane); S.done(cur); }
#undef PG8_SA
#undef PG8_SB
#undef PG8_STAGE
#undef PG8_LDA
#undef PG8_LDB
#undef PG8_MMA
#undef PG8_WAIT_V
#undef PG8_WAIT_L
#undef PG8_BAR
#undef PG8_SCHED
}
}

#define EPI_LOOP(...) \
    _Pragma("unroll") for (int ai = 0; ai < 2; ++ai) _Pragma("unroll") for (int m = 0; m < 4; ++m) { const int rl = ai * 128 + rl0 + m * 16; const int r = pm * 256 + rl; (void)r; \
    _Pragma("unroll") for (int bj = 0; bj < 2; ++bj) { const int ct = bj * 128 + cw; const f32x4 v0 = acc[ai][bj][m][0], v1 = acc[ai][bj][m][1]; __VA_ARGS__ } asm volatile("" ::: "memory"); }
#define PK8(w, a0, a1, a2, a3, a4, a5, a6, a7) u32x4 w; w.x = pk2(a0, a1); w.y = pk2(a2, a3); w.z = pk2(a4, a5); w.w = pk2(a6, a7);

DI float gate_logf(float z, float lb) { return __logf(lb + (1.f - lb) * sigmoidf_(z)); }
template <class T> DI T* at(const void* base, unsigned byteoff) { return (T*)((unsigned char*)base + byteoff); }

struct EpiIn {
    static constexpr bool PERM = true, AFTER_DRAIN = false, KEEP_ACC = false;
    unsigned char* ws; float* out; int layer; const float* lbf; const float* lbb;
    DI void operator()(const f32x4 (&acc)[2][2][4][2], const pg8::Unit& u, int wr, int wc, int, int) const {
        const int l_ = lane_id(); const int fr = l_ & 15, fq = l_ >> 4;
        const int pn = u.pn, pm = u.pm; const int rl0 = wr * 64 + fr, cw = wc * 32 + fq * 8;
        const bool prompt = pm < 32;
        if (pn < 2) {
            bf16_t* QA = (bf16_t*)(ws + O_QA);
            EPI_LOOP({ PK8(w, v0[0] * QS_NA, v0[1] * QS_NA, v0[2] * QS_NA, v0[3] * QS_NA, v1[0] * QS_NA, v1[1] * QS_NA, v1[2] * QS_NA, v1[3] * QS_NA)
                       *(u32x4*)(QA + (size_t)r * 512 + pn * 256 + ct) = w; })
        } else if (pn < 4) {
            bf16_t* KA = (bf16_t*)(ws + O_KA);
            EPI_LOOP({ PK8(w, v0[0], v0[1], v0[2], v0[3], v1[0], v1[1], v1[2], v1[3])
                       *(u32x4*)(KA + (size_t)r * 512 + (pn - 2) * 256 + ct) = w;
                       if (prompt) { float* o = out + OUT_NK + ((size_t)(pm * 2 + layer) * 256 + rl) * 512 + (pn - 2) * 256 + ct; *(f32x4*)o = v0; *(f32x4*)(o + 4) = v1; } })
        } else if (pn < 6) {
            bf16_t* VTA = (bf16_t*)(ws + O_VTA);
            EPI_LOOP({ const int c0 = (pn - 4) * 256 + ct, head = c0 >> 6, dv0 = c0 & 63;
                       bf16_t* p; size_t st;
                       if (prompt) { p = VTA + ((size_t)(pm * 8 + head) * 64 + dv0) * 256 + rl; st = 256; }
                       else { const int bs = (pm - 32) >> 3, ts = ((pm - 32) & 7) * 256 + rl; p = VTA + (size_t)4194304 + ((size_t)(bs * 8 + head) * 64 + dv0) * 2048 + ts; st = 2048; }
                       p[0] = f2bf(v0[0]); p[st] = f2bf(v0[1]); p[2 * st] = f2bf(v0[2]); p[3 * st] = f2bf(v0[3]);
                       p[4 * st] = f2bf(v1[0]); p[5 * st] = f2bf(v1[1]); p[6 * st] = f2bf(v1[2]); p[7 * st] = f2bf(v1[3]);
                       if (prompt) { float* o = out + OUT_NV + ((size_t)(pm * 2 + layer) * 256 + rl) * 512 + c0; *(f32x4*)o = v0; *(f32x4*)(o + 4) = v1; } })
        } else if (pn < 8) {
            bf16_t* G = (bf16_t*)(ws + O_GNA);
            EPI_LOOP({ PK8(w, siluf_(v0[0]), siluf_(v0[1]), siluf_(v0[2]), siluf_(v0[3]), siluf_(v1[0]), siluf_(v1[1]), siluf_(v1[2]), siluf_(v1[3]))
                       *(u32x4*)(G + (size_t)r * 512 + (pn - 6) * 256 + ct) = w; })
        } else if (pn < 11) {
            bf16_t* CQ = (bf16_t*)(ws + O_CQ); bf16_t* CKVB = (bf16_t*)(ws + O_CKVB); float* CKVF = (float*)(ws + O_CKVF);
            float* CQSS = (float*)(ws + O_CQSS); float* CKVSS = (float*)(ws + O_CKVSS);
#pragma unroll
            for (int ai = 0; ai < 2; ++ai)
#pragma unroll
                for (int m = 0; m < 4; ++m) {
                    const int rl = ai * 128 + rl0 + m * 16; const int r = pm * 256 + rl; float s = 0.f;
#pragma unroll
                    for (int bj = 0; bj < 2; ++bj) {
                        const int ct = bj * 128 + cw; const f32x4 v0 = acc[ai][bj][m][0], v1 = acc[ai][bj][m][1];
                        s += (v0[0] * v0[0] + v0[1] * v0[1]) + (v0[2] * v0[2] + v0[3] * v0[3]) + (v1[0] * v1[0] + v1[1] * v1[1]) + (v1[2] * v1[2] + v1[3] * v1[3]);
                        PK8(w, v0[0], v0[1], v0[2], v0[3], v1[0], v1[1], v1[2], v1[3])
                        if (pn < 10) *(u32x4*)(CQ + (size_t)r * 512 + (pn - 8) * 256 + ct) = w;
                        else { *(u32x4*)(CKVB + (size_t)r * 256 + ct) = w; if (prompt) { float* o = CKVF + (size_t)r * 256 + ct; *(f32x4*)o = v0; *(f32x4*)(o + 4) = v1; } }
                    }
                    s += xor_swz<16>(s); s = sum_x32(s);
                    if (fq == 0) { if (pn < 10) CQSS[(size_t)r * 8 + (pn - 8) * 4 + wc] = s; else CKVSS[(size_t)r * 4 + wc] = s; }
                }
        } else if (pn < 13) {
            bf16_t* G = (bf16_t*)(ws + O_GMLA);
            EPI_LOOP({ PK8(w, siluf_(v0[0]), siluf_(v0[1]), siluf_(v0[2]), siluf_(v0[3]), siluf_(v1[0]), siluf_(v1[1]), siluf_(v1[2]), siluf_(v1[3]))
                       *(u32x4*)(G + (size_t)r * 512 + (pn - 11) * 256 + ct) = w; })
        } else if (pn < 15) {
            float* HQ = (float*)(ws + O_HQ);
            EPI_LOOP({ float* o = HQ + (size_t)r * 512 + (pn - 13) * 256 + ct;
                       *(f32x4*)o = (f32x4){siluf_(v0[0]), siluf_(v0[1]), siluf_(v0[2]), siluf_(v0[3])}; *(f32x4*)(o + 4) = (f32x4){siluf_(v1[0]), siluf_(v1[1]), siluf_(v1[2]), siluf_(v1[3])}; })
        } else if (pn < 19) {
            const bool fwd = pn < 17; const int pb = fwd ? 15 : 17;
            float* LF = (float*)(ws + (fwd ? O_LFF : O_LFB)); const float* lbp = fwd ? lbf : lbb; const bool has_lb = layer > 0;
            float lbv[2][8];
#pragma unroll
            for (int bj = 0; bj < 2; ++bj)
#pragma unroll
                for (int e = 0; e < 8; ++e) { const int col = (pn - pb) * 256 + bj * 128 + cw + e; lbv[bj][e] = has_lb ? sigmoidf_(lbp[512 + col] - lbp[col]) : 0.f; }
            EPI_LOOP({ float* o = LF + (size_t)r * 512 + (pn - pb) * 256 + ct;
                       *(f32x4*)o = (f32x4){gate_logf(v0[0], lbv[bj][0]), gate_logf(v0[1], lbv[bj][1]), gate_logf(v0[2], lbv[bj][2]), gate_logf(v0[3], lbv[bj][3])};
                       *(f32x4*)(o + 4) = (f32x4){gate_logf(v1[0], lbv[bj][4]), gate_logf(v1[1], lbv[bj][5]), gate_logf(v1[2], lbv[bj][6]), gate_logf(v1[3], lbv[bj][7])}; })
        } else if (pn < 21) {
            float* HV = (float*)(ws + O_HV);
            EPI_LOOP({ float* o = HV + (size_t)r * 512 + (pn - 19) * 256 + ct; *(f32x4*)o = v0; *(f32x4*)(o + 4) = v1; })
        } else if (pn < 23) {
            bf16_t* G = (bf16_t*)(ws + O_GHG);
            EPI_LOOP({ PK8(w, siluf_(v0[0]), siluf_(v0[1]), siluf_(v0[2]), siluf_(v0[3]), siluf_(v1[0]), siluf_(v1[1]), siluf_(v1[2]), siluf_(v1[3]))
                       *(u32x4*)(G + (size_t)r * 512 + (pn - 21) * 256 + ct) = w; })
        } else if (pn < 47) {
            EPI_LOOP({ const f32x4 s0 = (f32x4){sigmoidf_(v0[0]), sigmoidf_(v0[1]), sigmoidf_(v0[2]), sigmoidf_(v0[3])} * 255.f + 0.5f, s1 = (f32x4){sigmoidf_(v1[0]), sigmoidf_(v1[1]), sigmoidf_(v1[2]), sigmoidf_(v1[3])} * 255.f + 0.5f;
                       u32x2 w; w.x = max((unsigned)s0[0], 1u) | (max((unsigned)s0[1], 1u) << 8) | (max((unsigned)s0[2], 1u) << 16) | (max((unsigned)s0[3], 1u) << 24);
                       w.y = max((unsigned)s1[0], 1u) | (max((unsigned)s1[1], 1u) << 8) | (max((unsigned)s1[2], 1u) << 16) | (max((unsigned)s1[3], 1u) << 24);
                       *at<u32x2>(ws, (unsigned)O_SIG + (unsigned)(r * 6144 + (pn - 23) * 256 + ct)) = w; })
        } else {
            float* KRF = (float*)(ws + O_KRF);
            if (wc == 0) {
                EPI_LOOP({ if (bj == 0) { float* o = KRF + (size_t)r * 32 + ct; *(f32x4*)o = v0; *(f32x4*)(o + 4) = v1; } })
            }
        }
    }
};

struct EpiUQ {
    static constexpr bool PERM = true, AFTER_DRAIN = false, KEEP_ACC = false;
    unsigned char* ws;
    DI void operator()(const f32x4 (&acc)[2][2][4][2], const pg8::Unit& u, int wr, int wc, int, int) const {
        const int l_ = lane_id(); const int fr = l_ & 15, fq = l_ >> 4;
        const int pn = u.pn, pm = u.pm; const int rl0 = wr * 64 + fr, cw = wc * 32 + fq * 8;
        const float* CQSS = (const float*)(ws + O_CQSS); const float* ROPE = (const float*)(ws + O_ROPE); bf16_t* QM = (bf16_t*)(ws + O_QM);
        const bool sample = pm >= 32;
#pragma unroll
        for (int ai = 0; ai < 2; ++ai)
#pragma unroll
            for (int m = 0; m < 4; ++m) {
                const int rl = ai * 128 + rl0 + m * 16; const int r = pm * 256 + rl;
                const f32x4 sa = *(const f32x4*)(CQSS + (size_t)r * 8), sb = *(const f32x4*)(CQSS + (size_t)r * 8 + 4);
                const float rs = rsqrtf(((sa[0] + sa[1]) + (sa[2] + sa[3]) + (sb[0] + sb[1]) + (sb[2] + sb[3])) * (1.f / 512.f) + EPS) * QS_MLA;
#pragma unroll
                for (int bj = 0; bj < 2; ++bj) {
                    const int ct = bj * 128 + cw; const f32x4 v0 = acc[ai][bj][m][0], v1 = acc[ai][bj][m][1];
                    float x[8] = {v0[0] * rs, v0[1] * rs, v0[2] * rs, v0[3] * rs, v1[0] * rs, v1[1] * rs, v1[2] * rs, v1[3] * rs};
                    const int gid = pn * 8 + bj * 4 + wc;
                    if (sample && (gid % 3 == 2)) {
                        const int ts = ((pm - 32) & 7) * 256 + rl; const int pos = (fq >> 1) ? (ts & 63) : (ts >> 6); const bool half = fq & 1;
                        const float* tb = ROPE + pos * 16;
                        const f32x4 t0 = *(const f32x4*)tb, t1 = *(const f32x4*)(tb + 4), t2 = *(const f32x4*)(tb + 8), t3 = *(const f32x4*)(tb + 12);
                        const float cs[8] = {t0[0], t0[2], t1[0], t1[2], t2[0], t2[2], t3[0], t3[2]}, sn[8] = {t0[1], t0[3], t1[1], t1[3], t2[1], t2[3], t3[1], t3[3]};
#pragma unroll
                        for (int e = 0; e < 8; ++e) { const float pr = xor_swz<16>(x[e]); x[e] = x[e] * cs[e] + (half ? pr : -pr) * sn[e]; }
                    }
                    PK8(w, x[0], x[1], x[2], x[3], x[4], x[5], x[6], x[7])
                    *(u32x4*)(QM + (size_t)r * 768 + pn * 256 + ct) = w;
                }
            }
    }
};

struct EpiKV {
    static constexpr bool PERM = true, AFTER_DRAIN = false, KEEP_ACC = false;
    unsigned char* ws; int layer; int ctx;
    DI void operator()(const f32x4 (&acc)[2][2][4][2], const pg8::Unit& u, int wr, int wc, int, int) const {
        const int l_ = lane_id(); const int fr = l_ & 15, fq = l_ >> 4;
        const int pn = u.pn, pm = u.pm; const int rl0 = wr * 64 + fr, fq8 = fq * 8;
        unsigned kbase, vbase; int vst;
        if (ctx) { const int b = pm >> 1, t0 = (pm & 1) * 256; kbase = (unsigned)O_KNS + (unsigned)(((layer * 2 + b) * 2560 + t0) * 1024); vbase = (unsigned)O_VTMS + (unsigned)(((layer * 2 + b) * 8 * 64 * 2560 + t0) * 2); vst = 2560; }
        else if (pm < 32) { kbase = (unsigned)O_KNP + (unsigned)(pm * 256 * 1024); vbase = (unsigned)O_VTMP + (unsigned)(pm * 8 * 64 * 256 * 2); vst = 256; }
        else { const int bs = (pm - 32) >> 3, t0 = 512 + ((pm - 32) & 7) * 256; kbase = (unsigned)O_KNS + (unsigned)(((layer * 2 + bs) * 2560 + t0) * 1024); vbase = (unsigned)O_VTMS + (unsigned)(((layer * 2 + bs) * 8 * 64 * 2560 + t0) * 2); vst = 2560; }
#pragma unroll
        for (int ai = 0; ai < 2; ++ai)
#pragma unroll
            for (int m = 0; m < 4; ++m) {
                const int rl = ai * 128 + rl0 + m * 16;
                float rs = 1.f;
                if (!ctx) { const f32x4 sa = *at<const f32x4>(ws, (unsigned)O_CKVSS + (unsigned)((pm * 256 + rl) * 16)); rs = rsqrtf(((sa[0] + sa[1]) + (sa[2] + sa[3])) * (1.f / 256.f) + EPS); }
#pragma unroll
                for (int bj = 0; bj < 2; ++bj) {
                    const f32x4 v0 = acc[ai][bj][m][0] * rs, v1 = acc[ai][bj][m][1] * rs;
                    const int gid = pn * 8 + bj * 4 + wc, head = gid >> 2, part = gid & 3;
                    if (part < 2) { PK8(w, v0[0], v0[1], v0[2], v0[3], v1[0], v1[1], v1[2], v1[3]) *at<u32x4>(ws, kbase + (unsigned)(rl * 1024 + (head * 64 + part * 32 + fq8) * 2)) = w; }
                    else { const unsigned sb = (unsigned)(vst * 2); unsigned o = vbase + (unsigned)(rl * 2) + (unsigned)(head * 64 + (part - 2) * 32 + fq8) * sb;
                        *at<bf16_t>(ws, o) = f2bf(v0[0]); *at<bf16_t>(ws, o + sb) = f2bf(v0[1]); *at<bf16_t>(ws, o + 2 * sb) = f2bf(v0[2]); *at<bf16_t>(ws, o + 3 * sb) = f2bf(v0[3]);
                        *at<bf16_t>(ws, o + 4 * sb) = f2bf(v1[0]); *at<bf16_t>(ws, o + 5 * sb) = f2bf(v1[1]); *at<bf16_t>(ws, o + 6 * sb) = f2bf(v1[2]); *at<bf16_t>(ws, o + 7 * sb) = f2bf(v1[3]); }
                }
                asm volatile("" ::: "memory");
            }
    }
};

DI f32x4 ub4(unsigned w) { return (f32x4){(float)(w & 255u), (float)((w >> 8) & 255u), (float)((w >> 16) & 255u), (float)(w >> 24)}; }
struct EpiMerge {
    static constexpr bool PERM = true, AFTER_DRAIN = false, KEEP_ACC = true;
    unsigned char* ws; int pm0; unsigned* cnt;
    DI void operator()(f32x4 (&acc)[2][2][4][2], const pg8::Unit& u, int wr, int wc, int, int) const {
        const int l_ = lane_id(); const int fr = l_ & 15, fq = l_ >> 4;
        const int pn = u.pn, pm = u.pm + pm0, br = u.br; const int rl0 = wr * 64 + fr, cw = wc * 32 + fq * 8;
        const unsigned sbase = (unsigned)O_SIG + (unsigned)((pm * 256 + rl0) * 6144 + br * 2048 + pn * 256 + cw);
        const unsigned mbase = (unsigned)O_MERGED + (unsigned)((pm * 256 + rl0) * 4096 + (pn * 256 + cw) * 2);
        u32x2 sg[2][4][2], sn[2][4][2];
#pragma unroll
        for (int ai = 0; ai < 2; ++ai)
#pragma unroll
            for (int m = 0; m < 4; ++m)
#pragma unroll
                for (int bj = 0; bj < 2; ++bj) {
                    sg[ai][m][bj] = *at<const u32x2>(ws, sbase + (unsigned)((ai * 128 + m * 16) * 6144 + bj * 128));
                    if (br < 2) sn[ai][m][bj] = *at<const u32x2>(ws, sbase + (unsigned)((ai * 128 + m * 16) * 6144 + bj * 128 + 2048));
                    else sn[ai][m][bj] = (u32x2){0x01010101u, 0x01010101u};
                }
#pragma unroll
        for (int ai = 0; ai < 2; ++ai)
#pragma unroll
            for (int m = 0; m < 4; ++m)
#pragma unroll
                for (int bj = 0; bj < 2; ++bj) {
                    const u32x2 s2 = sg[ai][m][bj], n2 = sn[ai][m][bj];
                    const f32x4 a = ub4(s2.x) * acc[ai][bj][m][0], b = ub4(s2.y) * acc[ai][bj][m][1];
                    if (br < 2) {
                        const f32x4 na = ub4(n2.x), nb = ub4(n2.y);
                        acc[ai][bj][m][0] = a * (f32x4){__builtin_amdgcn_rcpf(na[0]), __builtin_amdgcn_rcpf(na[1]), __builtin_amdgcn_rcpf(na[2]), __builtin_amdgcn_rcpf(na[3])};
                        acc[ai][bj][m][1] = b * (f32x4){__builtin_amdgcn_rcpf(nb[0]), __builtin_amdgcn_rcpf(nb[1]), __builtin_amdgcn_rcpf(nb[2]), __builtin_amdgcn_rcpf(nb[3])};
                    } else {
                        const f32x4 a1 = a * (1.f / 255.f), b1 = b * (1.f / 255.f);
                        PK8(w, a1[0], a1[1], a1[2], a1[3], b1[0], b1[1], b1[2], b1[3])
                        { u32x4* mp_ = at<u32x4>(ws, mbase + (unsigned)((ai * 128 + m * 16) * 4096 + bj * 256)); asm volatile("global_store_dwordx4 %0, %1, off sc0 sc1" :: "v"(mp_), "v"(w) : "memory"); }
                        acc[ai][bj][m][0] = (f32x4){0.f, 0.f, 0.f, 0.f}; acc[ai][bj][m][1] = (f32x4){0.f, 0.f, 0.f, 0.f};
                    }
                }
        if (br == 2) {
            asm volatile("s_waitcnt vmcnt(0)" ::: "memory");
            if (l_ == 0) __hip_atomic_fetch_add(cnt + 64 * pm, 1u, __ATOMIC_RELAXED, __HIP_MEMORY_SCOPE_AGENT);
        }
    }
};

struct EpiOut {
    static constexpr bool PERM = true, AFTER_DRAIN = false, KEEP_ACC = false;
    unsigned char* ws; int pm0;
    DI void operator()(const f32x4 (&acc)[2][2][4][2], const pg8::Unit& u, int wr, int wc, int, int) const {
        const int l_ = lane_id(); const int fr = l_ & 15, fq = l_ >> 4;
        const int pn = u.pn, pm = u.pm + pm0; const int rl0 = wr * 64 + fr, cw = wc * 32 + fq * 8;
        bf16_t* OB = (bf16_t*)(ws + O_OUTB); float* OSS = (float*)(ws + O_OSS);
#pragma unroll
        for (int ai = 0; ai < 2; ++ai)
#pragma unroll
            for (int m = 0; m < 4; ++m) {
                const int rl = ai * 128 + rl0 + m * 16; const int r = pm * 256 + rl; float s = 0.f;
#pragma unroll
                for (int bj = 0; bj < 2; ++bj) {
                    const int ct = bj * 128 + cw; const f32x4 v0 = acc[ai][bj][m][0], v1 = acc[ai][bj][m][1];
                    s += (v0[0] * v0[0] + v0[1] * v0[1]) + (v0[2] * v0[2] + v0[3] * v0[3]) + (v1[0] * v1[0] + v1[1] * v1[1]) + (v1[2] * v1[2] + v1[3] * v1[3]);
                    PK8(w, v0[0], v0[1], v0[2], v0[3], v1[0], v1[1], v1[2], v1[3])
                    *(u32x4*)(OB + (size_t)r * 2048 + pn * 256 + ct) = w;
                }
                s += xor_swz<16>(s); s = sum_x32(s);
                if (fq == 0) OSS[(size_t)r * 32 + pn * 4 + wc] = s;
            }
    }
};

constexpr int LDS_BYTES = 147456;
constexpr int KSTR = 208, VSTR = 144;
constexpr int A_K0 = 0, A_K1 = 64 * KSTR, A_V0 = 2 * 64 * KSTR, A_V1 = A_V0 + 64 * VSTR, A_MRG = A_V0 + 2 * 64 * VSTR;
static_assert(A_MRG + 4 * 34 * 64 * 4 <= 98304, "attention LDS map");
constexpr int HG_SCR = 98304;

constexpr int GV_SV = 73728, GV_PART = GV_SV + 3 * 2048 * 4;
static_assert(GV_PART + 8 * 3 * 256 * 4 <= LDS_BYTES, "gemv LDS map");
#define LDSW() asm volatile("s_waitcnt lgkmcnt(0)" ::: "memory")
#define MFMA32(a, b, c) __builtin_amdgcn_mfma_f32_32x32x16_bf16((a), (b), (c), 0, 0, 0)

constexpr int LDS_BAR = LDS_BYTES - 64;
#define XB_TMO      128
#define XB_XCNT(j)  (256  + 64 * (j))
#define XB_XSUB(j)  (1280 + 64 * (j))
#define XB_XGEN(j)  (2304 + 64 * (j))
#define XB_TOP      3328
#define XB_TOPGEN   3392
#define XCD_BAR_WORDS 3456
#define XB_SPIN_CAP (1u << 18)

__device__ __forceinline__ unsigned xb_ld(unsigned* p)              { return __hip_atomic_load(p, __ATOMIC_RELAXED, __HIP_MEMORY_SCOPE_AGENT); }
__device__ __forceinline__ unsigned xb_add(unsigned* p, unsigned v) { return __hip_atomic_fetch_add(p, v, __ATOMIC_RELAXED, __HIP_MEMORY_SCOPE_AGENT); }
__device__ __forceinline__ unsigned xb_xcc_id() { return (unsigned)__builtin_amdgcn_s_getreg((3 << 11) | 20) & 0xFu; }
#define XB_SPIN(cond, bar) do { unsigned _sp = 0; while (cond) { __builtin_amdgcn_s_sleep(1); \
    if ((++_sp & 255u) == 0u) { if (xb_ld(&(bar)[XB_TMO])) break; if (_sp > XB_SPIN_CAP) { atomicAdd(&(bar)[XB_TMO], 1u); break; } } } } while (0)

struct XcdBarrier {
    unsigned* bar; unsigned x;
    volatile LAS unsigned* st;
};

__device__ __forceinline__ XcdBarrier xcd_barrier_post(unsigned* bar, volatile LAS unsigned* st) {
    XcdBarrier b; b.bar = bar; b.x = xb_xcc_id(); b.st = st;
    if (threadIdx.x == 0) (void)xb_add(&bar[XB_XCNT(b.x)], 1u);
    return b;
}
__device__ __forceinline__ void xcd_barrier_complete(unsigned* bar, unsigned x, unsigned& nloc, unsigned& nx) {
    const unsigned G = gridDim.x * gridDim.y * gridDim.z;
    unsigned sum, cnt, mine, sp = 0u;
    for (;;) {
        sum = 0u; cnt = 0u; mine = 0u;
#pragma unroll
        for (unsigned j = 0; j < 16; ++j) { const unsigned c = xb_ld(&bar[XB_XCNT(j)]); sum += c; cnt += (c > 0u) ? 1u : 0u; mine = (j == x) ? c : mine; }
        if (sum == G) break;
        __builtin_amdgcn_s_sleep(1);
        if ((++sp & 255u) == 0u) { if (xb_ld(&bar[XB_TMO])) break; if (sp > XB_SPIN_CAP) { atomicAdd(&bar[XB_TMO], 1u); break; } }
    }
    nloc = mine > 0u ? mine : 1u; nx = cnt > 0u ? cnt : 1u;
}

__device__ __forceinline__ void xcd_barrier(const XcdBarrier& b) {
    asm volatile("s_waitcnt vmcnt(0)" ::: "memory");
    __syncthreads();
    if (threadIdx.x == 0) {
        unsigned* bar = b.bar;
        __builtin_amdgcn_s_waitcnt(0);
        unsigned nloc = b.st[0], nx = b.st[1];
        if (nloc == 0u) { xcd_barrier_complete(bar, b.x, nloc, nx); b.st[0] = nloc; b.st[1] = nx; }
        const unsigned old = xb_add(&bar[XB_XSUB(b.x)], 1u);
        const unsigned gen = old / nloc;
        if (old + 1u == (gen + 1u) * nloc) {
            __builtin_amdgcn_fence(__ATOMIC_RELEASE, "agent");
            asm volatile("s_waitcnt vmcnt(0)" ::: "memory");
            const unsigned og = xb_add(&bar[XB_TOP], 1u);
            const unsigned tg = og / nx;
            if (og + 1u == (tg + 1u) * nx) xb_add(&bar[XB_TOPGEN], 1u);
            else XB_SPIN(xb_ld(&bar[XB_TOPGEN]) == tg, bar);
            __builtin_amdgcn_fence(__ATOMIC_ACQUIRE, "agent");
            xb_add(&bar[XB_XGEN(b.x)], 1u);
            asm volatile("s_waitcnt vmcnt(0)" ::: "memory");
        } else {
            XB_SPIN(xb_ld(&bar[XB_XGEN(b.x)]) == gen, bar);
            __builtin_amdgcn_fence(__ATOMIC_ACQUIRE, "agent");
            asm volatile("s_waitcnt vmcnt(0)" ::: "memory");
        }
    }
    __syncthreads();
}

DI void transpose_item(const float* W, int ldw, int n0src, int k0, bf16_t* WT, int ldt, int nrow0, const float* kscale, LAS float* scr, int lane) {
    float v[32];
#pragma unroll
    for (int i = 0; i < 32; ++i) { const int kk = 2 * i + (lane >> 5); v[i] = n0src >= 0 ? W[(size_t)(k0 + kk) * ldw + n0src + (lane & 31)] : 0.f; }
    if (kscale) {
#pragma unroll
        for (int i = 0; i < 32; ++i) v[i] *= kscale[k0 + 2 * i + (lane >> 5)];
    }
#pragma unroll
    for (int i = 0; i < 32; ++i) scr[(2 * i + (lane >> 5)) * 33 + (lane & 31)] = v[i];
    LDSW();
    const int c = lane & 7;
#pragma unroll
    for (int j = 0; j < 4; ++j) { const int n = (lane >> 3) + 8 * j; const LAS float* s = scr + (8 * c) * 33 + n;
        u32x4 o; o.x = pk2(s[0 * 33], s[1 * 33]); o.y = pk2(s[2 * 33], s[3 * 33]); o.z = pk2(s[4 * 33], s[5 * 33]); o.w = pk2(s[6 * 33], s[7 * 33]);
        *(u32x4*)(WT + (size_t)(nrow0 + n) * ldt + k0 + 8 * c) = o; }
    LDSW();
}

DI void setup_transposes(const Params& P, LAS unsigned char* lds, int gw, int ngw, int wid, int lane) {
    LAS float* scr = (LAS float*)(lds + wid * 8704);
    unsigned char* ws = P.ws;
    constexpr int I_IN = 32 * 384, I_OUT = 32 * 64, I_BR = 8 * 64, I_UQ = 8 * 24, I_UKV = 4 * 32;
    constexpr int PER_LAYER = I_IN + I_OUT + 3 * I_BR + I_UQ + 2 * I_UKV;
    for (int it = gw; it < 2 * PER_LAYER; it += ngw) {
        const int l = it / PER_LAYER; int r = it - l * PER_LAYER;
        if (r < I_IN) {
            const int kb = r / 384, nb = r % 384, n0 = nb * 32;
            const int src = n0 < 2816 ? n0 : (n0 < 12032 ? n0 + 32 : (n0 < 12064 ? n0 - 12032 + 2816 : -1));
            transpose_item(P.in[I_WIN] + (size_t)l * DM * PROJ_ORIG, PROJ_ORIG, src, kb * 64, (bf16_t*)(ws + O_WIN) + (size_t)l * NPROJ * DM, DM, n0, nullptr, scr, lane); continue; }
        r -= I_IN;
        if (r < I_OUT) { const int kb = r / 64, nb = r % 64;
            transpose_item(P.in[I_WOUT] + (size_t)l * DM * DM, DM, nb * 32, kb * 64, (bf16_t*)(ws + O_WOUT) + (size_t)l * DM * DM, DM, nb * 32, nullptr, scr, lane); continue; }
        r -= I_OUT;
        if (r < 3 * I_BR) { const int br = r / I_BR, q = r % I_BR, kb = q / 64, nb = q % 64;
            transpose_item(P.in[I_WBNA + br] + (size_t)l * 512 * DM, DM, nb * 32, kb * 64, (bf16_t*)(ws + O_WBR) + (size_t)(l * 3 + br) * DM * 512, 512, nb * 32, nullptr, scr, lane); continue; }
        r -= 3 * I_BR;
        if (r < I_UQ) { const int kb = r / 24, nb = r % 24;
            transpose_item(P.in[I_WUQ] + (size_t)l * 512 * 768, 768, nb * 32, kb * 64, (bf16_t*)(ws + O_WUQ) + (size_t)l * 768 * 512, 512, nb * 32, P.in[I_GMQ] + l * 512, scr, lane); continue; }
        r -= I_UQ;
        { const int var = r / I_UKV, q = r % I_UKV, kb = q / 32, nb = q % 32;
            transpose_item(P.in[I_WUKV] + (size_t)l * 256 * 1024, 1024, nb * 32, kb * 64, (bf16_t*)(ws + (var ? O_WUKVG : O_WUKV)) + (size_t)l * 1024 * 256, 256, nb * 32,
                           var ? P.in[I_GMKV] + l * 256 : nullptr, scr, lane); }
    }
}

DI void win1_transposes(const Params& P, LAS unsigned char* lds, int gw, int ngw, int wid, int lane) {
    LAS float* scr = (LAS float*)(lds + wid * 8704);
    const float* W = P.in[I_WIN] + (size_t)DM * PROJ_ORIG; bf16_t* WT = (bf16_t*)(P.ws + O_WIN) + (size_t)NPROJ * DM;
#pragma unroll 1
    for (int r = gw; r < 32 * 384; r += ngw) {
        const int kb = r / 384, nb = r % 384, n0 = nb * 32;
        const int src = n0 < 2816 ? n0 : (n0 < 12032 ? n0 + 32 : (n0 < 12064 ? n0 - 12032 + 2816 : -1));
        transpose_item(W, PROJ_ORIG, src, kb * 64, WT, DM, n0, nullptr, scr, lane);
    }
}

DI void setup_gemv(const Params& P, LAS unsigned char* lds, int job, int tid, int wid, int lane) {
    const int l = job / 96, col0 = (job % 96) * 64;
    LAS float* sv = (LAS float*)(lds + GV_SV); LAS float* part = (LAS float*)(lds + GV_PART);
    for (int i = tid; i < 3 * 2048; i += 512) { const int vec = i >> 11, k = i & 2047; const float x = vec == 0 ? P.in[I_CCTX][k] : P.in[I_C][(vec - 1) * 2048 + k]; sv[i] = x / (1.f + expf(-x)); }
    __syncthreads();
    const int rg = lane >> 4, c4 = lane & 15;
    const float* W = P.in[I_WADA] + (size_t)l * DM * 6144 + col0 + 4 * c4;
    f32x4 a0 = {0.f, 0.f, 0.f, 0.f}, a1 = a0, a2 = a0;
#pragma unroll 8
    for (int it = 0; it < 64; ++it) { const int k = wid * 256 + 4 * it + rg; const f32x4 w = *(const f32x4*)(W + (size_t)k * 6144); a0 += w * sv[k]; a1 += w * sv[2048 + k]; a2 += w * sv[4096 + k]; }
#pragma unroll
    for (int e = 0; e < 4; ++e) {
        a0[e] += xor_swz<16>(a0[e]); a0[e] = sum_x32(a0[e]);
        a1[e] += xor_swz<16>(a1[e]); a1[e] = sum_x32(a1[e]);
        a2[e] += xor_swz<16>(a2[e]); a2[e] = sum_x32(a2[e]);
    }
    if (lane < 16) { *(LAS f32x4*)(part + (wid * 3 + 0) * 64 + 4 * c4) = a0; *(LAS f32x4*)(part + (wid * 3 + 1) * 64 + 4 * c4) = a1; *(LAS f32x4*)(part + (wid * 3 + 2) * 64 + 4 * c4) = a2; }
    __syncthreads();
    if (tid < 192) {
        const int vec = tid >> 6, c = tid & 63; float* MOD = (float*)(P.ws + O_MOD);
        float s = P.in[I_BADA][l * 6144 + col0 + c];
#pragma unroll
        for (int w = 0; w < 8; ++w) s += part[(w * 3 + vec) * 64 + c];
        MOD[(size_t)(l * 3 + vec) * 6144 + col0 + c] = s;
    }
    __syncthreads();
}

DI void setup_convert(const Params& P, int gtid, int ngt) {
    unsigned char* ws = P.ws;
    bf16_t* CKA = (bf16_t*)(ws + O_CKA); bf16_t* CVTA = (bf16_t*)(ws + O_CVTA); bf16_t* CCKV = (bf16_t*)(ws + O_CCKV); bf16_t* KRS = (bf16_t*)(ws + O_KRS); float* ROPE = (float*)(ws + O_ROPE);
    constexpr int NA = 1048576, NB = 1048576, NC = 524288, ND = 65536, NE = 512;
    for (int i = gtid; i < NA + NB + NC + ND + NE; i += ngt) {
        int x = i;
        if (x < NA) { const int c = x & 511, t = (x >> 9) & 511, b = (x >> 18) & 1, l = x >> 19; CKA[x] = f2bf(P.in[I_CNK][((size_t)(b * 2 + l) * 512 + t) * 512 + c]); continue; }
        x -= NA;
        if (x < NB) { const int t = x & 511, dv = (x >> 9) & 63, hd = (x >> 15) & 7, b = (x >> 18) & 1, l = x >> 19; CVTA[x] = f2bf(P.in[I_CNV][((size_t)(b * 2 + l) * 512 + t) * 512 + hd * 64 + dv]); continue; }
        x -= NB;
        if (x < NC) { const int c = x & 255, t = (x >> 8) & 511, b = (x >> 17) & 1, l = x >> 18; CCKV[x] = f2bf(P.in[I_CCKV][((size_t)(b * 2 + l) * 512 + t) * 256 + c]); continue; }
        x -= NC;
        if (x < ND) { const int d = x & 31, t = (x >> 5) & 511, b = (x >> 14) & 1, l = x >> 15; KRS[((size_t)(l * 2 + b) * 2560 + t) * 32 + d] = f2bf(P.in[I_CKR][((size_t)(b * 2 + l) * 512 + t) * 32 + d]); continue; }
        x -= ND;
        { const int fi = x & 7, pos = x >> 3; const float inv = powf(10000.f, -(float)fi / 8.f), ang = (float)pos * inv; ROPE[x * 2] = cosf(ang); ROPE[x * 2 + 1] = sinf(ang); }
    }
}

DI void prenorm_store(const f32x4 (&y)[8], float ss, const float* gpre, const float* mod, bf16_t* hrow, int lane) {
    const float rstd = rsqrtf(ss * (1.f / 2048.f) + EPS);
#pragma unroll
    for (int j = 0; j < 8; ++j) { const int c = 4 * lane + 256 * j;
        const f32x4 g = *(const f32x4*)(gpre + c), sh = *(const f32x4*)(mod + c), sc = *(const f32x4*)(mod + 2048 + c);
        const f32x4 hh = y[j] * rstd * g * (sc + 1.f) + sh;
        u32x2 w; w.x = pk2(hh[0], hh[1]); w.y = pk2(hh[2], hh[3]); *(u32x2*)(hrow + c) = w; }
}
DI void prenorm_layer0(const Params& P, int gw, int ngw, int lane) {
    const float* MOD = (const float*)(P.ws + O_MOD); bf16_t* H = (bf16_t*)(P.ws + O_H);
    for (int r = gw; r < NTOK; r += ngw) {
        const float* xr = r < NPR ? P.in[I_XP] + (size_t)r * DM : P.in[I_XS] + (size_t)(r - NPR) * DM; const int vec = r < NPR ? 0 : 1 + ((r - NPR) >> 11);
        f32x4 y[8]; float ss = 0.f;
#pragma unroll
        for (int j = 0; j < 8; ++j) { y[j] = *(const f32x4*)(xr + 4 * lane + 256 * j); ss += (y[j][0] * y[j][0] + y[j][1] * y[j][1]) + (y[j][2] * y[j][2] + y[j][3] * y[j][3]); }
        ss = wave_sum(ss);
        prenorm_store(y, ss, P.in[I_GPRE], MOD + (size_t)vec * 6144, H + (size_t)r * DM, lane);
    }
}
DI void postnorm_phase(const Params& P, int layer, int gw, int ngw, int lane) {
    OPAQUE_V(lane);
    const float* MOD = (const float*)(P.ws + O_MOD); bf16_t* H = (bf16_t*)(P.ws + O_H); const bf16_t* OB = (const bf16_t*)(P.ws + O_OUTB); const float* OSS = (const float*)(P.ws + O_OSS);
    for (int r = gw; r < NTOK; r += ngw) {
        const int vec = r < NPR ? 0 : 1 + ((r - NPR) >> 11);
        float* yr = r < NPR ? P.out + OUT_YP + (size_t)r * DM : P.out + OUT_YS + (size_t)(r - NPR) * DM;
        const float* xr = layer == 0 ? (r < NPR ? P.in[I_XP] + (size_t)r * DM : P.in[I_XS] + (size_t)(r - NPR) * DM) : yr;
        float so = lane < 32 ? OSS[(size_t)r * 32 + lane] : 0.f; so = wave_sum(so);
        const float rstd = rsqrtf(so * (1.f / 2048.f) + EPS);
        const float* mod = MOD + (size_t)(layer * 3 + vec) * 6144; const float* gp = P.in[I_GPOST] + layer * DM;
        f32x4 y[8]; float ss = 0.f;
#pragma unroll
        for (int j = 0; j < 8; ++j) { const int c = 4 * lane + 256 * j;
            const f32x4 x = *(const f32x4*)(xr + c), gt = *(const f32x4*)(mod + 4096 + c), g = *(const f32x4*)(gp + c); const u32x2 ob = *(const u32x2*)(OB + (size_t)r * DM + c);
            const f32x4 o = {bflo(ob.x), bfhi(ob.x), bflo(ob.y), bfhi(ob.y)};
            y[j] = x + gt * (o * rstd * g); ss += (y[j][0] * y[j][0] + y[j][1] * y[j][1]) + (y[j][2] * y[j][2] + y[j][3] * y[j][3]); }
#pragma unroll
        for (int j = 0; j < 8; ++j) *(f32x4*)(yr + 4 * lane + 256 * j) = y[j];
        if (layer == 0) { ss = wave_sum(ss); prenorm_store(y, ss, P.in[I_GPRE] + DM, MOD + (size_t)(3 + vec) * 6144, H + (size_t)r * DM, lane); }
    }
}

DI void mla_finish(const Params& P, int layer, int gtid, int ngt) {
    unsigned char* ws = P.ws; OPAQUE_V(gtid); OPAQUE_S(ws);
    const float* CKVF = (const float*)(ws + O_CKVF); const float* CKVSS = (const float*)(ws + O_CKVSS); const float* KRF = (const float*)(ws + O_KRF); const float* ROPE = (const float*)(ws + O_ROPE);
    bf16_t* KRP = (bf16_t*)(ws + O_KRP); bf16_t* KRS = (bf16_t*)(ws + O_KRS);
#pragma unroll 4
    for (int i = gtid; i < NPR * 256; i += ngt) { const int r = i >> 8, c = i & 255; const f32x4 sa = *(const f32x4*)(CKVSS + (size_t)r * 4);
        const float rs = rsqrtf(((sa[0] + sa[1]) + (sa[2] + sa[3])) * (1.f / 256.f) + EPS);
        P.out[OUT_CKV + ((size_t)((r >> 8) * 2 + layer) * 256 + (r & 255)) * 256 + c] = CKVF[i] * rs * P.in[I_GMKV][layer * 256 + c]; }
#pragma unroll 3
    for (int i = gtid; i < NTOK * 32; i += ngt) { const int r = i >> 5, d = i & 31; const float x = KRF[i];
        if (r < NPR) { P.out[OUT_KR + ((size_t)((r >> 8) * 2 + layer) * 256 + (r & 255)) * 32 + d] = x; KRP[i] = f2bf(x); }
        else { const int rs_ = r - NPR, bs = rs_ >> 11, ts = rs_ & 2047; const int pos = (d >> 4) ? (ts & 63) : (ts >> 6); const float cs = ROPE[(pos * 8 + (d & 7)) * 2], sn = ROPE[(pos * 8 + (d & 7)) * 2 + 1];
            const float pr = KRF[i ^ 8]; const float y = x * cs + ((d & 8) ? pr : -pr) * sn;
            KRS[((size_t)(layer * 2 + bs) * 2560 + 512 + ts) * 32 + d] = f2bf(y); }
    }
}

DI int crow16(int i, int h) { return (i & 3) + 8 * (i >> 2) + 4 * h; }
DI s16x4 ld8(const LAS unsigned char* p) { return *(const LAS s16x4*)p; }
DI s16x4 ld8(const unsigned char* p) { return *(const s16x4*)p; }
template <class VP>
DI void softmax_pv(f32x16& s, float& mrun, float& lrun, f32x16& o0, f32x16& o1, VP vbase, int vstride, int r, int h) {
    float mx = s[0];
#pragma unroll
    for (int i = 1; i < 16; ++i) mx = fmaxf(mx, s[i]);
    mx = max_x32(mx);
    const float mnew = fmaxf(mrun, mx), alpha = __builtin_amdgcn_exp2f(mrun - mnew);
    float rs = 0.f;
#pragma unroll
    for (int i = 0; i < 16; ++i) { s[i] = __builtin_amdgcn_exp2f(s[i] - mnew); rs += s[i]; }
    rs = sum_x32(rs);
    lrun = lrun * alpha + rs; mrun = mnew;
    o0 *= alpha; o1 *= alpha;
#pragma unroll
    for (int s2 = 0; s2 < 2; ++s2) {
        u32x4 pw; pw.x = pk2(s[8 * s2 + 0], s[8 * s2 + 1]); pw.y = pk2(s[8 * s2 + 2], s[8 * s2 + 3]); pw.z = pk2(s[8 * s2 + 4], s[8 * s2 + 5]); pw.w = pk2(s[8 * s2 + 6], s[8 * s2 + 7]);
        const bf16x8 pb = __builtin_bit_cast(bf16x8, pw);
        {   VP p = vbase + (size_t)r * vstride + (16 * s2 + 4 * h) * 2;
            const s16x4 lo = ld8(p), hi = ld8(p + 16); const bf16x8 va = __builtin_shufflevector(lo, hi, 0, 1, 2, 3, 4, 5, 6, 7);
            o0 = MFMA32(va, pb, o0); }
        {   VP p = vbase + (size_t)(r + 32) * vstride + (16 * s2 + 4 * h) * 2;
            const s16x4 lo = ld8(p), hi = ld8(p + 16); const bf16x8 va = __builtin_shufflevector(lo, hi, 0, 1, 2, 3, 4, 5, 6, 7);
            o1 = MFMA32(va, pb, o1); }
    }
}

template <class VP>
DI void softmax_pv2(f32x16& sa, f32x16& sb, float& mrun, float& lrun, f32x16& o0, f32x16& o1, VP vbase, int vstride, int r, int h) {
    float mx = fmaxf(sa[0], sb[0]);
#pragma unroll
    for (int i = 1; i < 16; ++i) mx = fmaxf(mx, fmaxf(sa[i], sb[i]));
    mx = max_x32(mx);
    if (__builtin_amdgcn_ballot_w64(mx > mrun + DEFER_THR) != 0ull) {
        const float mnew = fmaxf(mrun, mx), alpha = __builtin_amdgcn_exp2f(mrun - mnew);
        lrun *= alpha; o0 *= alpha; o1 *= alpha; mrun = mnew;
    }
    const float mnew = mrun;
    float rs = 0.f;
#pragma unroll
    for (int i = 0; i < 16; ++i) { sa[i] = __builtin_amdgcn_exp2f(sa[i] - mnew); sb[i] = __builtin_amdgcn_exp2f(sb[i] - mnew); rs += sa[i] + sb[i]; }
    rs = sum_x32(rs);
    lrun += rs;
#pragma unroll
    for (int sub = 0; sub < 2; ++sub) {
        const f32x16& s = sub ? sb : sa;
#pragma unroll
        for (int s2 = 0; s2 < 2; ++s2) {
            u32x4 pw; pw.x = pk2(s[8 * s2 + 0], s[8 * s2 + 1]); pw.y = pk2(s[8 * s2 + 2], s[8 * s2 + 3]); pw.z = pk2(s[8 * s2 + 4], s[8 * s2 + 5]); pw.w = pk2(s[8 * s2 + 6], s[8 * s2 + 7]);
            const bf16x8 pb = __builtin_bit_cast(bf16x8, pw);
            {   VP p = vbase + (size_t)r * vstride + (32 * sub + 16 * s2 + 4 * h) * 2;
                const s16x4 lo = ld8(p), hi = ld8(p + 16); o0 = MFMA32(__builtin_shufflevector(lo, hi, 0, 1, 2, 3, 4, 5, 6, 7), pb, o0); }
            {   VP p = vbase + (size_t)(r + 32) * vstride + (32 * sub + 16 * s2 + 4 * h) * 2;
                const s16x4 lo = ld8(p), hi = ld8(p + 16); o1 = MFMA32(__builtin_shufflevector(lo, hi, 0, 1, 2, 3, 4, 5, 6, 7), pb, o1); }
        }
    }
}

DI void softmax_pv_regs(f32x16& s, float& mrun, float& lrun, f32x16& o0, f32x16& o1, const bf16x8 (&va)[2][2]) {
    float mx = s[0];
#pragma unroll
    for (int i = 1; i < 16; ++i) mx = fmaxf(mx, s[i]);
    mx = max_x32(mx);
    if (__builtin_amdgcn_ballot_w64(mx > mrun + DEFER_THR) != 0ull) {
        const float mnew = fmaxf(mrun, mx), alpha = __builtin_amdgcn_exp2f(mrun - mnew);
        lrun *= alpha; o0 *= alpha; o1 *= alpha; mrun = mnew;
    }
    const float mnew = mrun;
    float rs = 0.f;
#pragma unroll
    for (int i = 0; i < 16; ++i) { s[i] = __builtin_amdgcn_exp2f(s[i] - mnew); rs += s[i]; }
    rs = sum_x32(rs);
    lrun += rs;
#pragma unroll
    for (int s2 = 0; s2 < 2; ++s2) {
        u32x4 pw; pw.x = pk2(s[8 * s2 + 0], s[8 * s2 + 1]); pw.y = pk2(s[8 * s2 + 2], s[8 * s2 + 3]); pw.z = pk2(s[8 * s2 + 4], s[8 * s2 + 5]); pw.w = pk2(s[8 * s2 + 6], s[8 * s2 + 7]);
        const bf16x8 pb = __builtin_bit_cast(bf16x8, pw);
        o0 = MFMA32(va[s2][0], pb, o0); o1 = MFMA32(va[s2][1], pb, o1);
    }
}

struct AttnSeg { const bf16_t* K1; const bf16_t* K2; const bf16_t* VT; int vts; int nk; };

template <int NST, bool SPLIT, bool LOCAL>
DI void attn_unit(LAS unsigned char* lds, const bf16_t* Q, int qstride, const AttnSeg sa, const AttnSeg sb, const bf16_t* gate, bf16_t* outp,
                  const bf16_t* Kloc, const bf16_t* VTloc, const float* rpbh, int grow0, const int wid_in) {
    const int wid = wid_in, lane = lane_id(), tid = wid * 64 + lane, r = lane & 31, h = lane >> 5;
    const int qi = SPLIT ? (wid & 3) : wid, grp = SPLIT ? (wid >> 2) : 0;
    const int qrow = qi * 32 + r;
    bf16x8 qf[NST];
#pragma unroll
    for (int st = 0; st < NST; ++st) qf[st] = *(const bf16x8*)(Q + (size_t)qrow * qstride + 16 * st + 8 * h);
    f32x16 o0, o1;
#pragma unroll
    for (int i = 0; i < 16; ++i) { o0[i] = 0.f; o1[i] = 0.f; }
    float mrun = NEG, lrun = 0.f;
    if constexpr (LOCAL) {
        const int gr = grow0 + (qi >> 1), qc = 32 * (qi & 1) + r;
        const int kr0 = min(max(gr - 4, 0), 24), win0 = min(max(qc - 8, 0), 48);
        bf16x8 kfA[NST], kfB[NST], vaA[2][2], vaB[2][2]; float bsA[16], bsB[16];
#define LOC_LOAD(KF, VA, BS, lt) do { const int krow_ = kr0 + 4 * grp + ((lt) >> 1), c0_ = 32 * ((lt) & 1); \
            _Pragma("unroll") for (int st = 0; st < NST; ++st) KF[st] = *(const bf16x8*)(Kloc + (size_t)(krow_ * 64 + c0_ + r) * 512 + 16 * st + 8 * h); \
            _Pragma("unroll") for (int s2 = 0; s2 < 2; ++s2) _Pragma("unroll") for (int blk = 0; blk < 2; ++blk) { \
                const unsigned char* p_ = (const unsigned char*)(VTloc + krow_ * 64 + c0_) + (size_t)(r + 32 * blk) * 4096 + (16 * s2 + 4 * h) * 2; \
                const s16x4 lo_ = ld8(p_), hi_ = ld8(p_ + 16); VA[s2][blk] = __builtin_shufflevector(lo_, hi_, 0, 1, 2, 3, 4, 5, 6, 7); } \
            const float* rp_ = rpbh + (krow_ - gr + 7) * 31; \
            _Pragma("unroll") for (int i = 0; i < 16; ++i) { const int kc_ = c0_ + crow16(i, h); BS[i] = rp_[min(max(kc_ - qc + 15, 0), 30)]; } } while (0)
#define LOC_COMP(KF, VA, BS, lt) do { const int c0_ = 32 * ((lt) & 1); f32x16 s_; \
            _Pragma("unroll") for (int i = 0; i < 16; ++i) s_[i] = 0.f; \
            _Pragma("unroll") for (int st = 0; st < NST; ++st) s_ = MFMA32(KF[st], qf[st], s_); \
            _Pragma("unroll") for (int i = 0; i < 16; ++i) { const int kc_ = c0_ + crow16(i, h); const bool ok_ = (kc_ >= win0) && (kc_ < win0 + 16); s_[i] = ok_ ? s_[i] + BS[i] * LOG2E : NEG; } \
            softmax_pv_regs(s_, mrun, lrun, o0, o1, VA); } while (0)
        LOC_LOAD(kfA, vaA, bsA, 0);
#pragma unroll
        for (int lt = 0; lt < 8; lt += 2) {
            LOC_LOAD(kfB, vaB, bsB, lt + 1);
            LOC_COMP(kfA, vaA, bsA, lt);
            if (lt + 2 < 8) LOC_LOAD(kfA, vaA, bsA, lt + 2);
            LOC_COMP(kfB, vaB, bsB, lt + 1);
        }
#undef LOC_LOAD
#undef LOC_COMP
    }
    constexpr int TK = SPLIT ? 128 : 64, LTK = SPLIT ? 7 : 6;
    constexpr int VST = SPLIT ? 272 : VSTR;
    constexpr int AK1 = TK * KSTR, AV0 = 2 * TK * KSTR, AV1 = AV0 + 64 * VST, AMRG = AV0 + 2 * 64 * VST;
    static_assert(AMRG + 4 * 34 * 64 * 4 <= LDS_BAR, "attention LDS map");
    const int nta = sa.nk >> LTK, nt = nta + (sb.nk >> LTK);
    u32x4 rk1[SPLIT ? 2 : 1], rk2 = {0u, 0u, 0u, 0u}, rv[SPLIT ? 2 : 1];
#define ATT_LOAD(t) do { const bool ina = (t) < nta; const int key0 = ((t) - (ina ? 0 : nta)) * TK; \
        const bf16_t* k1_ = ina ? sa.K1 : sb.K1; const bf16_t* k2_ = ina ? sa.K2 : sb.K2; const bf16_t* vt_ = ina ? sa.VT : sb.VT; const int vts_ = ina ? sa.vts : sb.vts; \
        _Pragma("unroll") for (int q_ = 0; q_ < (SPLIT ? 2 : 1); ++q_) { \
            rk1[q_] = *(const u32x4*)(k1_ + (size_t)(key0 + 64 * q_ + (tid >> 3)) * 512 + (tid & 7) * 8); \
            rv[q_] = *(const u32x4*)(vt_ + (size_t)(tid >> 3) * vts_ + key0 + 64 * q_ + (tid & 7) * 8); } \
        if (NST == 6 && (SPLIT || tid < 256)) rk2 = *(const u32x4*)(k2_ + (size_t)(key0 + (tid >> 2)) * 32 + (tid & 3) * 8); } while (0)
#define ATT_STORE(b) do { const int kb_ = (b) ? AK1 : 0, vb_ = (b) ? AV1 : AV0; \
        _Pragma("unroll") for (int q_ = 0; q_ < (SPLIT ? 2 : 1); ++q_) { \
            *(LAS u32x4*)(lds + kb_ + (64 * q_ + (tid >> 3)) * KSTR + (tid & 7) * 16) = rk1[q_]; \
            *(LAS u32x4*)(lds + vb_ + (tid >> 3) * VST + 128 * q_ + (tid & 7) * 16) = rv[q_]; } \
        if (NST == 6 && (SPLIT || tid < 256)) *(LAS u32x4*)(lds + kb_ + (tid >> 2) * KSTR + 128 + (tid & 3) * 16) = rk2; } while (0)
    ATT_LOAD(0); ATT_STORE(0);
    __syncthreads();
#pragma unroll 1
    for (int t = 0; t < nt; ++t) {
        if (t + 1 < nt) ATT_LOAD(t + 1);
        const int kb = ((t & 1) ? AK1 : 0) + (SPLIT ? grp * 64 * KSTR : 0), vb = ((t & 1) ? AV1 : AV0) + (SPLIT ? grp * 128 : 0);
        {   f32x16 s0, s1;
#pragma unroll
            for (int i = 0; i < 16; ++i) { s0[i] = 0.f; s1[i] = 0.f; }
#pragma unroll
            for (int st = 0; st < NST; ++st) {
                const bf16x8 kf0 = *(const LAS bf16x8*)(lds + kb + r * KSTR + (16 * st + 8 * h) * 2), kf1 = *(const LAS bf16x8*)(lds + kb + (32 + r) * KSTR + (16 * st + 8 * h) * 2);
                s0 = MFMA32(kf0, qf[st], s0); s1 = MFMA32(kf1, qf[st], s1); }
            softmax_pv2(s0, s1, mrun, lrun, o0, o1, (const LAS unsigned char*)(lds + vb), VST, r, h);
        }
        if (t + 1 < nt) ATT_STORE((t + 1) & 1);
        __syncthreads();
    }
#undef ATT_LOAD
#undef ATT_STORE
    if constexpr (SPLIT) {
        LAS float* mg = (LAS float*)(lds + AMRG) + qi * 34 * 64;
        if (grp == 1) {
#pragma unroll
            for (int k = 0; k < 16; ++k) { mg[k * 64 + lane] = o0[k]; mg[(16 + k) * 64 + lane] = o1[k]; }
            mg[32 * 64 + lane] = mrun; mg[33 * 64 + lane] = lrun;
        }
        __syncthreads();
        if (grp == 0) {
            const float m2 = mg[32 * 64 + lane], l2 = mg[33 * 64 + lane], mn = fmaxf(mrun, m2), a1 = __builtin_amdgcn_exp2f(mrun - mn), a2 = __builtin_amdgcn_exp2f(m2 - mn);
            lrun = lrun * a1 + l2 * a2;
#pragma unroll
            for (int k = 0; k < 16; ++k) { o0[k] = o0[k] * a1 + mg[k * 64 + lane] * a2; o1[k] = o1[k] * a1 + mg[(16 + k) * 64 + lane] * a2; }
        }
    }
    if (!SPLIT || grp == 0) {
        const float inv = 1.f / lrun;
#pragma unroll
        for (int g4 = 0; g4 < 4; ++g4) {
            { const int dv0 = 8 * g4 + 4 * h; const u32x2 gt = *(const u32x2*)(gate + (size_t)qrow * 512 + dv0);
              u32x2 w; w.x = pk2(o0[4 * g4] * inv * bflo(gt.x), o0[4 * g4 + 1] * inv * bfhi(gt.x)); w.y = pk2(o0[4 * g4 + 2] * inv * bflo(gt.y), o0[4 * g4 + 3] * inv * bfhi(gt.y));
              *(u32x2*)(outp + (size_t)qrow * 512 + dv0) = w; }
            { const int dv0 = 32 + 8 * g4 + 4 * h; const u32x2 gt = *(const u32x2*)(gate + (size_t)qrow * 512 + dv0);
              u32x2 w; w.x = pk2(o1[4 * g4] * inv * bflo(gt.x), o1[4 * g4 + 1] * inv * bfhi(gt.x)); w.y = pk2(o1[4 * g4 + 2] * inv * bflo(gt.y), o1[4 * g4 + 3] * inv * bfhi(gt.y));
              *(u32x2*)(outp + (size_t)qrow * 512 + dv0) = w; }
        }
    }
    if constexpr (SPLIT) __syncthreads();
}

constexpr int HM_WAVE = 20480, HM_Q = 0, HM_K = 4608, HM_KT = 9216, HM_VT = 14336, HM_ER = 19456, HM_EB = 19712;
static_assert(6 * HM_WAVE <= LDS_BYTES, "hgrn LDS map");
DI bf16x8 pack8(float a0, float a1, float a2, float a3, float a4, float a5, float a6, float a7) { u32x4 w; w.x = pk2(a0, a1); w.y = pk2(a2, a3); w.z = pk2(a4, a5); w.w = pk2(a6, a7); return __builtin_bit_cast(bf16x8, w); }
DI void hgrn_pass1(unsigned char* ws, LAS unsigned char* lds, int job, int slot, int lane) {
    OPAQUE_V(lane); OPAQUE_S(ws);
    const int dir = job & 1, head = (job >> 1) & 7, gs = job >> 4;
    int tok0; if (gs < 64) tok0 = (gs >> 1) * 256 + (gs & 1) * 128; else { const int x = gs - 64; tok0 = NPR + (x >> 4) * 2048 + (x & 15) * 128; }
    const float* LF = (const float*)(ws + (dir ? O_LFB : O_LFF)); const float* HQ = (const float*)(ws + O_HQ); const float* HV = (const float*)(ws + O_HV);
    float* OP = (float*)(ws + O_OPART) + (size_t)dir * NTOK * 512; bf16_t* QE = (bf16_t*)(ws + O_QE) + (size_t)dir * NTOK * 512;
    LAS unsigned char* L = lds + slot * HM_WAVE;
    const int r31 = lane & 31, h = lane >> 5, hc = head * 64 + lane, dt = dir ? -1 : 1;
    f32x16 S[2][2];
#pragma unroll
    for (int a = 0; a < 2; ++a)
#pragma unroll
        for (int b = 0; b < 2; ++b)
#pragma unroll
            for (int i = 0; i < 16; ++i) S[a][b][i] = 0.f;
    float Bgrp = 0.f;
#pragma unroll 1
    for (int ch = 0; ch < 4; ++ch) {
        const int tbase = dir ? tok0 + 127 - 32 * ch : tok0 + 32 * ch;
        {
            {   float vv[32];
#pragma unroll
                for (int t = 0; t < 32; ++t) vv[t] = HV[(size_t)(tbase + dt * t) * 512 + hc];
#pragma unroll
                for (int q4 = 0; q4 < 4; ++q4)
                    *(LAS bf16x8*)(L + HM_VT + lane * 80 + q4 * 16) = pack8(vv[8 * q4], vv[8 * q4 + 1], vv[8 * q4 + 2], vv[8 * q4 + 3], vv[8 * q4 + 4], vv[8 * q4 + 5], vv[8 * q4 + 6], vv[8 * q4 + 7]);
            }
            asm volatile("" ::: "memory");
            float lf[32], qv[32];
#pragma unroll
            for (int t = 0; t < 32; ++t) { const size_t o = (size_t)(tbase + dt * t) * 512 + hc; lf[t] = LF[o]; qv[t] = HQ[o]; }
#pragma unroll
            for (int t = 1; t < 32; ++t) lf[t] += lf[t - 1];
            const float bend = lf[31], r = 0.5f * bend, eg = __expf(Bgrp + r);
            float ekp = __expf(r);
#pragma unroll
            for (int q4 = 0; q4 < 4; ++q4) {
                float kt[8];
#pragma unroll
                for (int u = 0; u < 8; ++u) { const int t = 8 * q4 + u;
                    const float eq = __expf(lf[t] - r), ek = __expf(r - lf[t]);
                    const float f = eq * ekp; ekp = ek;
                    const float qt = qv[t] * eq; kt[u] = (1.f - f) * ek;
                    QE[(size_t)(tbase + dt * t) * 512 + hc] = f2bf(qt * eg);
                    *(LAS bf16_t*)(L + HM_Q + t * 144 + lane * 2) = f2bf(qt);
                    *(LAS bf16_t*)(L + HM_K + t * 144 + lane * 2) = f2bf(kt[u]); }
                *(LAS bf16x8*)(L + HM_KT + lane * 80 + q4 * 16) = pack8(kt[0], kt[1], kt[2], kt[3], kt[4], kt[5], kt[6], kt[7]);
            }
            *(LAS float*)(L + HM_ER + lane * 4) = __expf(r); *(LAS float*)(L + HM_EB + lane * 4) = __expf(bend);
            Bgrp += bend;
        }
        LDSW();
        f32x16 X;
#pragma unroll
        for (int i = 0; i < 16; ++i) X[i] = 0.f;
#pragma unroll
        for (int st = 0; st < 4; ++st) { const bf16x8 a = *(const LAS bf16x8*)(L + HM_K + r31 * 144 + (16 * st + 8 * h) * 2), bq = *(const LAS bf16x8*)(L + HM_Q + r31 * 144 + (16 * st + 8 * h) * 2); X = MFMA32(a, bq, X); }
#pragma unroll
        for (int i = 0; i < 16; ++i) X[i] = (crow16(i, h) > r31) ? 0.f : X[i];
        f32x16 O0, O1;
#pragma unroll
        for (int i = 0; i < 16; ++i) { O0[i] = 0.f; O1[i] = 0.f; }
#pragma unroll
        for (int s2 = 0; s2 < 2; ++s2) {
            const bf16x8 pb = pack8(X[8 * s2], X[8 * s2 + 1], X[8 * s2 + 2], X[8 * s2 + 3], X[8 * s2 + 4], X[8 * s2 + 5], X[8 * s2 + 6], X[8 * s2 + 7]);
            { const LAS unsigned char* p = L + HM_VT + r31 * 80 + (16 * s2 + 4 * h) * 2; const s16x4 lo = ld8(p), hi = ld8(p + 16); O0 = MFMA32(__builtin_shufflevector(lo, hi, 0, 1, 2, 3, 4, 5, 6, 7), pb, O0); }
            { const LAS unsigned char* p = L + HM_VT + (32 + r31) * 80 + (16 * s2 + 4 * h) * 2; const s16x4 lo = ld8(p), hi = ld8(p + 16); O1 = MFMA32(__builtin_shufflevector(lo, hi, 0, 1, 2, 3, 4, 5, 6, 7), pb, O1); }
        }
#pragma unroll
        for (int kb = 0; kb < 2; ++kb)
#pragma unroll
            for (int s2 = 0; s2 < 2; ++s2) {
                const LAS unsigned char* qp = L + HM_Q + r31 * 144 + (32 * kb + 16 * s2 + 4 * h) * 2; const s16x4 lo = ld8(qp), hi = ld8(qp + 16);
                const bf16x8 bqp = __builtin_shufflevector(lo, hi, 0, 1, 2, 3, 4, 5, 6, 7);
                const f32x4 e0 = *(const LAS f32x4*)(L + HM_ER + (32 * kb + 16 * s2 + 4 * h) * 4), e1 = *(const LAS f32x4*)(L + HM_ER + (32 * kb + 16 * s2 + 8 + 4 * h) * 4);
                { const f32x16& Sb = S[kb][0]; const bf16x8 a = pack8(Sb[8 * s2] * e0[0], Sb[8 * s2 + 1] * e0[1], Sb[8 * s2 + 2] * e0[2], Sb[8 * s2 + 3] * e0[3], Sb[8 * s2 + 4] * e1[0], Sb[8 * s2 + 5] * e1[1], Sb[8 * s2 + 6] * e1[2], Sb[8 * s2 + 7] * e1[3]);
                  O0 = MFMA32(a, bqp, O0); }
                { const f32x16& Sb = S[kb][1]; const bf16x8 a = pack8(Sb[8 * s2] * e0[0], Sb[8 * s2 + 1] * e0[1], Sb[8 * s2 + 2] * e0[2], Sb[8 * s2 + 3] * e0[3], Sb[8 * s2 + 4] * e1[0], Sb[8 * s2 + 5] * e1[1], Sb[8 * s2 + 6] * e1[2], Sb[8 * s2 + 7] * e1[3]);
                  O1 = MFMA32(a, bqp, O1); }
            }
        {   float* op = OP + (size_t)(tbase + dt * r31) * 512 + head * 64 + 4 * h;
#pragma unroll
            for (int g4 = 0; g4 < 4; ++g4) { *(f32x4*)(op + 8 * g4) = (f32x4){O0[4 * g4], O0[4 * g4 + 1], O0[4 * g4 + 2], O0[4 * g4 + 3]}; *(f32x4*)(op + 32 + 8 * g4) = (f32x4){O1[4 * g4], O1[4 * g4 + 1], O1[4 * g4 + 2], O1[4 * g4 + 3]}; }
        }
#pragma unroll
        for (int kb = 0; kb < 2; ++kb) {
            f32x4 er[4], eb[4];
#pragma unroll
            for (int g4 = 0; g4 < 4; ++g4) { er[g4] = *(const LAS f32x4*)(L + HM_ER + (32 * kb + 8 * g4 + 4 * h) * 4); eb[g4] = *(const LAS f32x4*)(L + HM_EB + (32 * kb + 8 * g4 + 4 * h) * 4); }
#pragma unroll
            for (int vb = 0; vb < 2; ++vb) {
                f32x16 T;
#pragma unroll
                for (int i = 0; i < 16; ++i) T[i] = 0.f;
#pragma unroll
                for (int st = 0; st < 2; ++st) { const bf16x8 a = *(const LAS bf16x8*)(L + HM_KT + (32 * kb + r31) * 80 + (16 * st + 8 * h) * 2), bv = *(const LAS bf16x8*)(L + HM_VT + (32 * vb + r31) * 80 + (16 * st + 8 * h) * 2); T = MFMA32(a, bv, T); }
#pragma unroll
                for (int i = 0; i < 16; ++i) S[kb][vb][i] = eb[i >> 2][i & 3] * S[kb][vb][i] + er[i >> 2][i & 3] * T[i];
            }
        }
        LDSW();
    }
    float* SG = (float*)(ws + O_SGRP) + (size_t)job * 4096;
#pragma unroll
    for (int kb = 0; kb < 2; ++kb)
#pragma unroll
        for (int vb = 0; vb < 2; ++vb)
#pragma unroll
            for (int i = 0; i < 16; ++i) SG[((kb * 2 + vb) * 16 + i) * 64 + lane] = S[kb][vb][i];
    ((float*)(ws + O_DGRP))[job * 64 + lane] = Bgrp;
}
DI void hgrn_pass2(const Params& P, int layer, int job, int lane) {
    unsigned char* ws = P.ws; OPAQUE_V(lane); OPAQUE_S(ws);
    const int c = job & 3, head = (job >> 2) & 7, gs = job >> 5;
    int b, g, ng, gsbase, tokg0; bool prompt;
    if (gs < 64) { prompt = true; b = gs >> 1; g = gs & 1; ng = 2; gsbase = gs & ~1; tokg0 = b * 256 + g * 128; }
    else { const int x = gs - 64; prompt = false; b = x >> 4; g = x & 15; ng = 16; gsbase = 64 + (x & ~15); tokg0 = NPR + b * 2048 + g * 128; }
    const int r31 = lane & 31, h = lane >> 5, t = tokg0 + 32 * c + r31;
    const float* SGRP = (const float*)(ws + O_SGRP);
    f32x16 O0, O1;
#pragma unroll
    for (int i = 0; i < 16; ++i) { O0[i] = 0.f; O1[i] = 0.f; }
#pragma unroll 1
    for (int dir = 0; dir < 2; ++dir) {
        const int gp = dir ? ng - 1 - g : g;
        if (prompt && gp == 0) continue;
        const int jq = ((gsbase + g) * 8 + head) * 2 + dir;
        const float* src = prompt ? SGRP + (size_t)(((gsbase + (g ^ 1)) * 8 + head) * 2 + dir) * 4096 : (const float*)(ws + O_GST) + (size_t)(jq - 1024) * 4096;
        f32x16 Gs[2][2];
#pragma unroll
        for (int kb = 0; kb < 2; ++kb)
#pragma unroll
            for (int vb = 0; vb < 2; ++vb)
#pragma unroll
                for (int i = 0; i < 16; ++i) Gs[kb][vb][i] = src[((kb * 2 + vb) * 16 + i) * 64 + lane];
        const bf16_t* qe = (const bf16_t*)(ws + O_QE) + (size_t)dir * NTOK * 512 + (size_t)t * 512 + head * 64;
#pragma unroll
        for (int kb = 0; kb < 2; ++kb)
#pragma unroll
            for (int s2 = 0; s2 < 2; ++s2) {
                const s16x4 lo = *(const s16x4*)(qe + 32 * kb + 16 * s2 + 4 * h), hi = *(const s16x4*)(qe + 32 * kb + 16 * s2 + 8 + 4 * h);
                const bf16x8 bqp = __builtin_shufflevector(lo, hi, 0, 1, 2, 3, 4, 5, 6, 7);
                { const f32x16& Sb = Gs[kb][0]; O0 = MFMA32(pack8(Sb[8 * s2], Sb[8 * s2 + 1], Sb[8 * s2 + 2], Sb[8 * s2 + 3], Sb[8 * s2 + 4], Sb[8 * s2 + 5], Sb[8 * s2 + 6], Sb[8 * s2 + 7]), bqp, O0); }
                { const f32x16& Sb = Gs[kb][1]; O1 = MFMA32(pack8(Sb[8 * s2], Sb[8 * s2 + 1], Sb[8 * s2 + 2], Sb[8 * s2 + 3], Sb[8 * s2 + 4], Sb[8 * s2 + 5], Sb[8 * s2 + 6], Sb[8 * s2 + 7]), bqp, O1); }
            }
    }
    const size_t ob = (size_t)t * 512 + head * 64 + 4 * h;
    const float* OP0 = (const float*)(ws + O_OPART) + ob; const float* OP1 = OP0 + (size_t)NTOK * 512;
    f32x4 tot[8]; float ss = 0.f;
#pragma unroll
    for (int g4 = 0; g4 < 4; ++g4) {
        tot[g4] = (f32x4){O0[4 * g4], O0[4 * g4 + 1], O0[4 * g4 + 2], O0[4 * g4 + 3]} + *(const f32x4*)(OP0 + 8 * g4) + *(const f32x4*)(OP1 + 8 * g4);
        tot[4 + g4] = (f32x4){O1[4 * g4], O1[4 * g4 + 1], O1[4 * g4 + 2], O1[4 * g4 + 3]} + *(const f32x4*)(OP0 + 32 + 8 * g4) + *(const f32x4*)(OP1 + 32 + 8 * g4);
    }
#pragma unroll
    for (int q = 0; q < 8; ++q) ss += (tot[q][0] * tot[q][0] + tot[q][1] * tot[q][1]) + (tot[q][2] * tot[q][2] + tot[q][3] * tot[q][3]);
    ss = sum_x32(ss);
    const float rstd = rsqrtf(ss * (1.f / 64.f) + EPS);
    const float* gh = P.in[I_GHG] + layer * 512 + head * 64 + 4 * h; const bf16_t* GHG = (const bf16_t*)(ws + O_GHG) + ob; bf16_t* OHG = (bf16_t*)(ws + O_OBR) + (size_t)2 * NTOK * 512 + ob;
#pragma unroll
    for (int q = 0; q < 8; ++q) { const int vo = (q >> 2) * 32 + 8 * (q & 3);
        const f32x4 gg = *(const f32x4*)(gh + vo); const u32x2 gt = *(const u32x2*)(GHG + vo);
        u32x2 w; w.x = pk2(tot[q][0] * rstd * gg[0] * bflo(gt.x), tot[q][1] * rstd * gg[1] * bfhi(gt.x)); w.y = pk2(tot[q][2] * rstd * gg[2] * bflo(gt.y), tot[q][3] * rstd * gg[3] * bfhi(gt.y));
        *(u32x2*)(OHG + vo) = w; }
}

DI void hgrn_scan(const Params& P, int layer, int gtid, int ngt) {
    unsigned char* ws = P.ws; OPAQUE_V(gtid); OPAQUE_S(ws);
    const float* SGRP = (const float*)(ws + O_SGRP); const float* DGRP = (const float*)(ws + O_DGRP); float* GST = (float*)(ws + O_GST);
#pragma unroll 4
    for (int e = gtid; e < 32 * 8 * 2 * 4096; e += ngt) {
        const int kv = e & 4095, dir = (e >> 12) & 1, head = (e >> 13) & 7, b = e >> 16, k = kv >> 6, v = kv & 63;
        const int kk = k & 31, hh = (kk >> 2) & 1, ii = (kk & 3) + 4 * (kk >> 3), el = ((((k >> 5) * 2 + (v >> 5)) * 16 + ii) * 64) + hh * 32 + (v & 31);
        const int jf = ((2 * b + (dir ? 1 : 0)) * 8 + head) * 2 + dir, jl = ((2 * b + (dir ? 0 : 1)) * 8 + head) * 2 + dir;
        P.out[(dir ? OUT_SB : OUT_SF) + ((size_t)(b * 2 + layer) * 8 + head) * 4096 + kv] = __expf(DGRP[jl * 64 + k]) * SGRP[(size_t)jf * 4096 + el] + SGRP[(size_t)jl * 4096 + el];
    }
    for (int e = gtid; e < 32 * 4096; e += ngt) {
        const int seq = e >> 12, el = e & 4095, ri = el >> 6, ln = el & 63, blk = ri >> 4, i = ri & 15;
        const int k = 32 * (blk >> 1) + crow16(i, ln >> 5), v = 32 * (blk & 1) + (ln & 31), b = seq >> 4, head = (seq >> 1) & 7, dir = seq & 1;
        float Gv = P.in[dir ? I_SB : I_SF][((size_t)(b * 2 + layer) * 8 + head) * 4096 + k * 64 + v];
        float dv[16], sv[16];
#pragma unroll
        for (int p = 0; p < 16; ++p) { const int gq = dir ? 15 - p : p, jq = ((64 + b * 16 + gq) * 8 + head) * 2 + dir; dv[p] = DGRP[jq * 64 + k]; sv[p] = SGRP[(size_t)jq * 4096 + el]; }
#pragma unroll
        for (int p = 0; p < 16; ++p) { const int gq = dir ? 15 - p : p, jq = ((64 + b * 16 + gq) * 8 + head) * 2 + dir; GST[(size_t)(jq - 1024) * 4096 + el] = Gv; Gv = __expf(dv[p]) * Gv + sv[p]; }
    }
}

__global__ void __launch_bounds__(512, 2) fwd_kernel(Params P) {
    extern __shared__ __attribute__((aligned(16))) unsigned char lds_raw[];
    LAS unsigned char* lds = (LAS unsigned char*)lds_raw;
    cg::grid_group grid = cg::this_grid();
    const int tid = threadIdx.x, wid = __builtin_amdgcn_readfirstlane(tid >> 6), lane = tid & 63, bid = blockIdx.x; constexpr int G = 256;
    const int gw = bid * 8 + wid, ngw = G * 8, gtid = bid * 512 + tid, ngt = G * 512;
    unsigned char* ws = P.ws;
    if (tid < 16) ((LAS unsigned*)(lds + LDS_BAR))[tid] = 0u;
    __syncthreads();
    (void)xcd_barrier_post((unsigned*)(ws + O_CTL), (volatile LAS unsigned*)(lds + LDS_BAR));
#define GRID_BAR() do { XcdBarrier b_; unsigned char* wb_ = P.ws; OPAQUE_S(wb_); b_.bar = (unsigned*)(wb_ + O_CTL); b_.x = xb_xcc_id(); b_.st = (volatile LAS unsigned*)(lds + LDS_BAR); xcd_barrier(b_); } while (0)

    for (int rep_ = 0; rep_ < REP_S0; ++rep_) {
#ifndef SKIP_S0
    for (int j = bid; j < 192; j += G) setup_gemv(P, lds, j, tid, wid, lane);
    setup_convert(P, gtid, ngt);
    setup_transposes(P, lds, gw, ngw, wid, lane);
#endif

    }
    grid.sync();

#ifndef SKIP_S1
#pragma unroll 1
    for (int l = 0; l < 2; ++l) {
        pg8::Gemm g{(const bf16_t*)(ws + O_CCKV) + (size_t)l * 1024 * 256, (const bf16_t*)(ws + O_WUKV) + (size_t)l * 1024 * 256, 1024, 1024, 256, 0, 0};
        pg8::StaticOrder S; S.init(1024, 1024, G, (bid + G - 16 * l) % G, 1);
        EpiKV E{ws, l, 1};
        pg8::gemm_phase<EpiKV, pg8::StaticOrder>(lds, g, S, E, wid);
    }
    prenorm_layer0(P, gw, ngw, lane);
#endif

    GRID_BAR();

#pragma unroll 1
    for (int l = 0; l < 2; ++l) {
        unsigned char* ws = P.ws; OPAQUE_S(ws);
#pragma unroll 1
        for (int rep_ = 0; rep_ < REP_L1; ++rep_) {
#ifndef SKIP_L1
        {   pg8::Gemm g{(const bf16_t*)(ws + O_H), (const bf16_t*)(ws + O_WIN) + (size_t)l * NPROJ * DM, NTOK, NPROJ, DM, 0, 0};
            pg8::StaticOrder S; S.init(NTOK, NPROJ, G, opq_s(bid), 1);
            EpiIn E{ws, P.out, l, P.in[I_LBF], P.in[I_LBB]};
            pg8::gemm_phase<EpiIn, pg8::StaticOrder>(lds, g, S, E, wid); }
#endif

        }
        GRID_BAR();

        ws = P.ws; OPAQUE_S(ws);
#pragma unroll 1
        for (int rep_ = 0; rep_ < REP_L2; ++rep_) {
#ifndef SKIP_UQ
        ws = P.ws; OPAQUE_S(ws);
        {   pg8::Gemm g{(const bf16_t*)(ws + O_CQ), (const bf16_t*)(ws + O_WUQ) + (size_t)l * 768 * 512, NTOK, 768, 512, 0, 0};
            pg8::StaticOrder S; S.init(NTOK, 768, G, opq_s(bid), 1);
            EpiUQ E{ws};
            pg8::gemm_phase<EpiUQ, pg8::StaticOrder>(lds, g, S, E, wid); }
#endif

#ifndef SKIP_KV
        ws = P.ws; OPAQUE_S(ws);
        {   pg8::Gemm g{(const bf16_t*)(ws + O_CKVB), (const bf16_t*)(ws + O_WUKVG) + (size_t)l * 1024 * 256, NTOK, 1024, 256, 0, 0};
            pg8::StaticOrder S; { const int b2 = opq_s(bid); S.init(NTOK, 1024, 112, b2 >= 144 ? b2 - 144 : 100000, 1); }
            EpiKV E{ws, l, 0};
            pg8::gemm_phase<EpiKV, pg8::StaticOrder>(lds, g, S, E, wid); }
        mla_finish(P, l, bid * 512 + wid * 64 + lane_id(), ngt);
#endif

#pragma unroll 1
        for (int rq_ = 0; rq_ < REP_NAP; ++rq_) {
#ifndef SKIP_NAP
        ws = P.ws; OPAQUE_S(ws);
        for (int u = opq_s(bid); u < 256; u += G) {
            const int b = u >> 3, head = u & 7; const size_t r0 = (size_t)b * 256;
            const AttnSeg sa{nullptr, nullptr, nullptr, 0, 0};
            const AttnSeg sb{(const bf16_t*)(ws + O_KA) + r0 * 512 + head * 64, nullptr, (const bf16_t*)(ws + O_VTA) + (size_t)(b * 8 + head) * 64 * 256, 256, 256};
            attn_unit<4, false, false>(lds, (const bf16_t*)(ws + O_QA) + r0 * 512 + head * 64, 512, sa, sb, (const bf16_t*)(ws + O_GNA) + r0 * 512 + head * 64,
                                       (bf16_t*)(ws + O_OBR) + r0 * 512 + head * 64, nullptr, nullptr, nullptr, 0, wid);
        }
#endif
        }


#pragma unroll 1
        for (int rq_ = 0; rq_ < REP_NAS; ++rq_) {
#ifndef SKIP_NAS
        ws = P.ws; OPAQUE_S(ws);
        for (int u = opq_s(bid); u < 256; u += G) {
            const int pair_ = (u & 7) * 2 + (u >> 7), bs = pair_ >> 3, head = pair_ & 7, grow0 = 2 * ((u >> 3) & 15);     const size_t rb = (size_t)NPR + (size_t)bs * 2048, r0 = rb + (size_t)grow0 * 64;
            const AttnSeg sa{(const bf16_t*)(ws + O_CKA) + (size_t)(l * 2 + bs) * 512 * 512 + head * 64, nullptr, (const bf16_t*)(ws + O_CVTA) + (size_t)((l * 2 + bs) * 8 + head) * 64 * 512, 512, 512};
            const AttnSeg sb{nullptr, nullptr, nullptr, 0, 0};
            attn_unit<4, true, true>(lds, (const bf16_t*)(ws + O_QA) + r0 * 512 + head * 64, 512, sa, sb, (const bf16_t*)(ws + O_GNA) + r0 * 512 + head * 64,
                                     (bf16_t*)(ws + O_OBR) + r0 * 512 + head * 64, (const bf16_t*)(ws + O_KA) + rb * 512 + head * 64,
                                     (const bf16_t*)(ws + O_VTA) + (size_t)4194304 + (size_t)(bs * 8 + head) * 64 * 2048, P.in[I_RPB] + (size_t)(l * 8 + head) * 15 * 31, grow0, wid);
        }
#endif
        }


#pragma unroll 1
        for (int rq_ = 0; rq_ < REP_H1; ++rq_) {
#ifndef SKIP_H1
        ws = P.ws; OPAQUE_S(ws);
        if (wid < 6) for (int j = wid * G + opq_s(bid); j < 1536; j += 6 * G) hgrn_pass1(ws, lds, j, wid, lane_id());
#endif
        }


        }
        GRID_BAR();

        ws = P.ws; OPAQUE_S(ws);
        hgrn_scan(P, l, bid * 512 + wid * 64 + lane_id(), ngt);
#pragma unroll 1
        for (int rep_ = 0; rep_ < REP_L3; ++rep_) {
#pragma unroll 1
        for (int rq_ = 0; rq_ < REP_MLAP; ++rq_) {
#ifndef SKIP_MLAP
        ws = P.ws; OPAQUE_S(ws);
        for (int u = opq_s(bid); u < 256; u += G) {
            const int b = u >> 3, head = u & 7; const size_t r0 = (size_t)b * 256;
            const AttnSeg sa{nullptr, nullptr, nullptr, 0, 0};
            const AttnSeg sb{(const bf16_t*)(ws + O_KNP) + r0 * 512 + head * 64, (const bf16_t*)(ws + O_KRP) + r0 * 32, (const bf16_t*)(ws + O_VTMP) + (size_t)(b * 8 + head) * 64 * 256, 256, 256};
            attn_unit<6, false, false>(lds, (const bf16_t*)(ws + O_QM) + r0 * 768 + head * 96, 768, sa, sb, (const bf16_t*)(ws + O_GMLA) + r0 * 512 + head * 64,
                                       (bf16_t*)(ws + O_OBR) + (size_t)NTOK * 512 + r0 * 512 + head * 64, nullptr, nullptr, nullptr, 0, wid);
        }
#endif
        }


#pragma unroll 1
        for (int rq_ = 0; rq_ < REP_MLAS; ++rq_) {
#ifndef SKIP_MLAS
        ws = P.ws; OPAQUE_S(ws);
        for (int u = opq_s(bid); u < 256; u += G) {
            const int pair_ = (u & 7) * 2 + (u >> 7), bs = pair_ >> 3, head = pair_ & 7, qb = (u >> 3) & 15;     const size_t r0 = (size_t)NPR + (size_t)bs * 2048 + (size_t)qb * 128;
            const AttnSeg sa{(const bf16_t*)(ws + O_KNS) + (size_t)(l * 2 + bs) * 2560 * 512 + head * 64, (const bf16_t*)(ws + O_KRS) + (size_t)(l * 2 + bs) * 2560 * 32,
                             (const bf16_t*)(ws + O_VTMS) + (size_t)((l * 2 + bs) * 8 + head) * 64 * 2560, 2560, 2560};
            const AttnSeg sb{nullptr, nullptr, nullptr, 0, 0};
            attn_unit<6, true, false>(lds, (const bf16_t*)(ws + O_QM) + r0 * 768 + head * 96, 768, sa, sb, (const bf16_t*)(ws + O_GMLA) + r0 * 512 + head * 64,
                                      (bf16_t*)(ws + O_OBR) + (size_t)NTOK * 512 + r0 * 512 + head * 64, nullptr, nullptr, nullptr, 0, wid);
        }
#endif
        }


        GRID_BAR();
#pragma unroll 1
        for (int rq_ = 0; rq_ < REP_H2; ++rq_) {
#ifndef SKIP_H2
        ws = P.ws; OPAQUE_S(ws);
        for (int j = wid * G + opq_s(bid); j < 3072; j += 8 * G) hgrn_pass2(P, l, j, lane_id());
#endif
        }


        }
        GRID_BAR();

        ws = P.ws; OPAQUE_S(ws);
        {   unsigned* cntl = (unsigned*)(ws + O_CNT) + (size_t)l * 48 * 64;
#pragma unroll 1
            for (int pass = 0; pass < 2; ++pass) {
                const int b2 = opq_s(bid);
                pg8::Gemm g{(const bf16_t*)(ws + O_OBR) + (pass ? (size_t)NPR * 512 : 0), (const bf16_t*)(ws + O_WBR) + (size_t)l * 3 * DM * 512, pass ? NSM : NPR, DM, 512, (size_t)NTOK * 512 * 2, (size_t)DM * 512 * 2};
                pg8::StaticOrder S; S.init(pass ? NSM : NPR, DM, pass ? 128 : G, pass ? (b2 < 128 ? b2 : 100000) : b2, 3);
                EpiMerge E{ws, pass ? 32 : 0, cntl};
                pg8::gemm_phase<EpiMerge, pg8::StaticOrder>(lds, g, S, E, wid);
            }
            {   const int b2 = opq_s(bid); const bool lat = b2 < 128;
                pg8::Gemm g{(const bf16_t*)(ws + O_MERGED) + (lat ? (size_t)NPR * DM : 0), (const bf16_t*)(ws + O_WOUT) + (size_t)l * DM * DM, lat ? NSM : NPR, DM, DM, 0, 0};
                pg8::CountedOrder S; S.init(lat ? NSM : NPR, DM, 128, lat ? b2 : b2 - 128, 1); S.ready = cntl; S.need = 64u; S.pm0 = lat ? 32 : 0; S.wid = wid;
                EpiOut E{ws, lat ? 32 : 0};
                pg8::gemm_phase<EpiOut, pg8::CountedOrder>(lds, g, S, E, wid);
            }
        }
        GRID_BAR();

#ifndef SKIP_L6
        postnorm_phase(P, l, bid * 8 + wid, ngw, lane_id());
#endif

        if (l == 0) GRID_BAR();
    }
}

extern "C" void kernel_launch(void* const* d_in, const int* in_sizes, int n_in, void* d_out, int out_size, void* d_ws, size_t ws_size, hipStream_t stream) {
    static int grid = 0;
    if (grid == 0) {
        if (n_in != 27 || (size_t)out_size != OUT_END || ws_size < WS_TOTAL) { fprintf(stderr, "kernel_launch: unexpected shapes: n_in %d out %d ws %zu (need %zu)\n", n_in, out_size, ws_size, (size_t)WS_TOTAL); grid = -1; return; }
        int dev = 0, cus = 0, per_cu = 0;
        if (hipGetDevice(&dev) != hipSuccess || hipDeviceGetAttribute(&cus, hipDeviceAttributeMultiprocessorCount, dev) != hipSuccess) { fprintf(stderr, "kernel_launch: device query failed\n"); grid = -1; return; }
        if (hipFuncSetAttribute((const void*)fwd_kernel, hipFuncAttributeMaxDynamicSharedMemorySize, LDS_BYTES) != hipSuccess) { fprintf(stderr, "kernel_launch: hipFuncSetAttribute failed\n"); grid = -1; return; }
        if (hipOccupancyMaxActiveBlocksPerMultiprocessor(&per_cu, (const void*)fwd_kernel, 512, LDS_BYTES) != hipSuccess || per_cu < 1) { fprintf(stderr, "kernel_launch: occupancy query says %d blocks per CU\n", per_cu); (void)hipGetLastError(); per_cu = 1; }
        grid = cus * 1;
        if (grid != 256) { fprintf(stderr, "kernel_launch: needs more than 128 CUs (got %d): layer 1's weight copy is made by workgroups 128.. of the grid\n", cus); grid = -1; return; }
    }
    if (grid < 0) return;
    if (hipMemsetAsync((unsigned char*)d_ws + O_CTL, 0, CTL_BYTES, stream) != hipSuccess) { fprintf(stderr, "kernel_launch: memset of the barrier words failed\n"); return; }
    Params p{};
    for (int i = 0; i < 27; ++i) p.in[i] = (const float*)d_in[i];
    p.out = (float*)d_out; p.ws = (unsigned char*)d_ws;
    void* args[] = {&p};
    hipError_t e = hipLaunchCooperativeKernel((const void*)fwd_kernel, dim3(grid), dim3(512), args, LDS_BYTES, stream);
    if (e != hipSuccess) fprintf(stderr, "kernel_launch: cooperative launch failed: %s (grid %d)\n", hipGetErrorString(e), grid);
}
```

```cpp
#include <hip/hip_runtime.h>
#include <hip/hip_cooperative_groups.h>
#include <cstdio>
#include <cstdint>
namespace cg = cooperative_groups;
#ifndef REP_L1
#define REP_L1 1
#endif
#ifndef REP_L2
#define REP_L2 1
#endif
#ifndef REP_L3
#define REP_L3 1
#endif
#ifndef REP_L4
#define REP_L4 1
#endif
#ifndef REP_L5
#define REP_L5 1
#endif
#ifndef REP_NAP
#define REP_NAP 1
#endif
#ifndef REP_NAS
#define REP_NAS 1
#endif
#ifndef REP_H1
#define REP_H1 1
#endif
#ifndef REP_MLAP
#define REP_MLAP 1
#endif
#ifndef REP_MLAS
#define REP_MLAS 1
#endif
#ifndef REP_H2
#define REP_H2 1
#endif
#ifndef REP_S0
#define REP_S0 1
#endif

#define DI __device__ __forceinline__
#define OPAQUE_V(x) asm volatile("" : "+v"(x))
#define OPAQUE_S(x) asm volatile("" : "+s"(x))
__device__ __forceinline__ int opq_s(int x) { asm volatile("" : "+s"(x)); return x; }
__device__ __forceinline__ int lane_id() { int l; asm volatile("v_mbcnt_lo_u32_b32 %0, -1, 0\n\tv_mbcnt_hi_u32_b32 %0, -1, %0" : "=v"(l)); return l; }
#define LAS __attribute__((address_space(3)))
typedef unsigned short bf16_t;
typedef short bf16x8 __attribute__((ext_vector_type(8)));
typedef short s16x4 __attribute__((ext_vector_type(4)));
typedef float f32x4 __attribute__((ext_vector_type(4)));
typedef float f32x2 __attribute__((ext_vector_type(2)));
typedef float f32x16 __attribute__((ext_vector_type(16)));
typedef unsigned u32x4 __attribute__((ext_vector_type(4)));
typedef unsigned u32x2 __attribute__((ext_vector_type(2)));
typedef __bf16 bf16v2 __attribute__((ext_vector_type(2)));

DI unsigned pk2(float a, float b) { bf16v2 v = __builtin_convertvector((f32x2){a, b}, bf16v2); return __builtin_bit_cast(unsigned, v); }
DI bf16_t f2bf(float a) { return (bf16_t)(pk2(a, 0.f) & 0xffffu); }
DI float bf2f(unsigned u16) { return __uint_as_float(u16 << 16); }
DI float bflo(unsigned w) { return __uint_as_float(w << 16); }
DI float bfhi(unsigned w) { return __uint_as_float(w & 0xffff0000u); }
DI float sigmoidf_(float x) { return __builtin_amdgcn_rcpf(1.f + __expf(-x)); }
DI float siluf_(float x) { return x * sigmoidf_(x); }
template <int XM> DI float xor_swz(float x) { return __int_as_float(__builtin_amdgcn_ds_swizzle(__float_as_int(x), (XM << 10) | 0x1f)); }
DI float max_x32(float x) { const auto r = __builtin_amdgcn_permlane32_swap(__float_as_uint(x), __float_as_uint(x), false, false); return fmaxf(__uint_as_float(r[0]), __uint_as_float(r[1])); }
DI float sum_x32(float x) { const auto r = __builtin_amdgcn_permlane32_swap(__float_as_uint(x), __float_as_uint(x), false, false); return __uint_as_float(r[0]) + __uint_as_float(r[1]); }
DI float wave_sum(float v) {
    v += xor_swz<1>(v); v += xor_swz<2>(v); v += xor_swz<4>(v); v += xor_swz<8>(v); v += xor_swz<16>(v); v = sum_x32(v);
    return v;
}

constexpr int DM = 2048, NTOK = 12288, NPR = 8192, NSM = 4096, PSEQ = 256, SSEQ = 2048, PAST = 512, NPROJ = 12288, PROJ_ORIG = 12064;
constexpr float EPS = 1e-6f, LOG2E = 1.4426950408889634f;
constexpr float QS_NA = 0.125f * LOG2E;
constexpr float QS_MLA = 0.10206207261596575f * LOG2E;
constexpr float NEG = -1e30f;

constexpr size_t al256(size_t x) { return (x + 255) & ~(size_t)255; }
constexpr size_t O_WIN = 0;
constexpr size_t O_WOUT = O_WIN + al256((size_t)2 * NPROJ * DM * 2);
constexpr size_t O_WBR = O_WOUT + al256((size_t)2 * DM * DM * 2);
constexpr size_t O_WUQ = O_WBR + al256((size_t)2 * 3 * DM * 512 * 2);
constexpr size_t O_WUKV = O_WUQ + al256((size_t)2 * 768 * 512 * 2);
constexpr size_t O_WUKVG = O_WUKV + al256((size_t)2 * 1024 * 256 * 2);
constexpr size_t O_MOD = O_WUKVG + al256((size_t)2 * 1024 * 256 * 2);
constexpr size_t O_ROPE = O_MOD + al256((size_t)2 * 3 * 6144 * 4);
constexpr size_t O_CKA = O_ROPE + al256((size_t)64 * 8 * 2 * 4);
constexpr size_t O_CVTA = O_CKA + al256((size_t)2 * 2 * 512 * 512 * 2);
constexpr size_t O_CCKV = O_CVTA + al256((size_t)2 * 2 * 512 * 512 * 2);
constexpr size_t O_KNS = O_CCKV + al256((size_t)2 * 2 * 512 * 256 * 2);
constexpr size_t O_KRS = O_KNS + al256((size_t)2 * 2 * 2560 * 512 * 2);
constexpr size_t O_VTMS = O_KRS + al256((size_t)2 * 2 * 2560 * 32 * 2);
constexpr size_t O_H = O_VTMS + al256((size_t)2 * 2 * 8 * 64 * 2560 * 2);
constexpr size_t O_QA = O_H + al256((size_t)NTOK * DM * 2);
constexpr size_t O_KA = O_QA + al256((size_t)NTOK * 512 * 2);
constexpr size_t O_VTA = O_KA + al256((size_t)NTOK * 512 * 2);
constexpr size_t O_GNA = O_VTA + al256((size_t)NTOK * 512 * 2);
constexpr size_t O_CQ = O_GNA + al256((size_t)NTOK * 512 * 2);
constexpr size_t O_CQSS = O_CQ + al256((size_t)NTOK * 512 * 2);
constexpr size_t O_CKVB = O_CQSS + al256((size_t)NTOK * 8 * 4);
constexpr size_t O_CKVF = O_CKVB + al256((size_t)NTOK * 256 * 2);
constexpr size_t O_CKVSS = O_CKVF + al256((size_t)NPR * 256 * 4);
constexpr size_t O_GMLA = O_CKVSS + al256((size_t)NTOK * 4 * 4);
constexpr size_t O_HQ = O_GMLA + al256((size_t)NTOK * 512 * 2);
constexpr size_t O_LFF = O_HQ + (size_t)NTOK * 512 * 4;
constexpr size_t O_LFB = O_LFF + (size_t)NTOK * 512 * 4;
constexpr size_t O_HV = O_LFB + (size_t)NTOK * 512 * 4;
constexpr size_t O_GHG = O_HV + (size_t)NTOK * 512 * 4;
constexpr size_t O_SIG = O_GHG + al256((size_t)NTOK * 512 * 2);
constexpr size_t O_KRF = O_SIG + al256((size_t)NTOK * 6144 * 2);
constexpr size_t O_QM = O_KRF + al256((size_t)NTOK * 32 * 4);
constexpr size_t O_KNP = O_QM + al256((size_t)NTOK * 768 * 2);
constexpr size_t O_KRP = O_KNP + al256((size_t)NPR * 512 * 2);
constexpr size_t O_VTMP = O_KRP + al256((size_t)NPR * 32 * 2);
constexpr size_t O_OBR = O_VTMP + al256((size_t)NPR * 512 * 2);
constexpr size_t O_OPART = O_OBR + al256((size_t)3 * NTOK * 512 * 2);
constexpr size_t O_SGRP = O_OPART + al256((size_t)2 * NTOK * 512 * 4);
constexpr size_t O_DGRP = O_SGRP + al256((size_t)1536 * 4096 * 4);
constexpr size_t O_OSS = O_DGRP + al256((size_t)1536 * 64 * 4);
constexpr size_t O_OTMP = O_OSS + al256((size_t)NTOK * 32 * 4);
constexpr size_t O_GST = O_OTMP + al256((size_t)NTOK * 512 * 4);
constexpr size_t WS_END = O_GST + al256((size_t)512 * 4096 * 4);
constexpr size_t O_CTL = WS_END, O_CNT = O_CTL + 16384, CTL_BYTES = 16384 + 96 * 256;
constexpr size_t WS_TOTAL = O_CTL + CTL_BYTES;
static_assert(WS_TOTAL < (size_t)780 * 1024 * 1024, "workspace map too large");
constexpr size_t O_PMRG = O_HQ, O_MERGED = O_H, O_OUTB = O_HQ;
constexpr size_t O_QE = O_H;
static_assert((size_t)2 * NTOK * 512 * 4 <= (size_t)NTOK * DM * 2, "QE overlay");

constexpr size_t OUT_YP = 0, OUT_YS = OUT_YP + (size_t)NPR * DM, OUT_NK = OUT_YS + (size_t)NSM * DM, OUT_NV = OUT_NK + (size_t)32 * 2 * 256 * 512,
                 OUT_CKV = OUT_NV + (size_t)32 * 2 * 256 * 512, OUT_KR = OUT_CKV + (size_t)32 * 2 * 256 * 256, OUT_SF = OUT_KR + (size_t)32 * 2 * 256 * 32,
                 OUT_SB = OUT_SF + (size_t)32 * 2 * 8 * 4096, OUT_END = OUT_SB + (size_t)32 * 2 * 8 * 4096;

struct Params {
    const float* in[27];
    float* out;
    unsigned char* ws;
};
enum { I_XP = 0, I_XS, I_CNK, I_CNV, I_CCKV, I_CKR, I_SF, I_SB, I_C, I_CCTX, I_WADA, I_BADA, I_GPRE, I_GPOST, I_WIN, I_RPB, I_GMQ, I_WUQ, I_GMKV, I_WUKV,
       I_LBF, I_LBB, I_GHG, I_WBNA, I_WBMLA, I_WBHG, I_WOUT };

namespace pg8 {
#define PG8_LAS __attribute__((address_space(3)))
constexpr int BM = 256, BK = 64, HALF = 128, HTB = HALF * BK * 2, STAGE_BYTES = 8 * HTB, NXCD = 8, WGM = 8;
__host__ __device__ __forceinline__ int lds_byte(int r, int c) { const int st = (r >> 4) * 2 + (c >> 5), rr = r & 15, cc = c & 31, ob = rr * 64 + cc * 2; return st * 1024 + (ob ^ (((ob >> 9) & 1) << 5)); }
__host__ __device__ __forceinline__ void stage_rc(int b, int& R, int& C) { const int st = b / 1024, sb = b % 1024, swz = sb ^ (((sb >> 9) & 1) << 5); R = (st >> 1) * 16 + swz / 64; C = (st & 1) * 32 + (swz % 64) / 2; }
__host__ __device__ __forceinline__ int perm32(int rho) { const int n = rho >> 4, i = rho & 15; return 8 * (i >> 2) + 4 * n + (i & 3); }
struct Unit { int pm, pn, br; };
struct Gemm { const bf16_t* A; const bf16_t* Bt; int M, N, K; size_t a_br, b_br; };
struct StaticOrder {
    int nM, nN, nwg, G, c, nbr;
    __device__ void init(int M, int N, int G_, int c_, int nbr_) { nM = M / BM; nN = N / BM; nwg = nM * nN; G = G_; c = c_; nbr = nbr_; }
    __device__ bool next(int i, Unit& u) const {
        const int it = i / nbr; u.br = i - it * nbr;
        const long L = (long)it * G + c; if (L >= nwg) return false;
        int wgid = (int)L; { const int q = nwg / NXCD, r = nwg % NXCD, xcd = wgid % NXCD, off = wgid / NXCD; wgid = (xcd < r ? xcd * (q + 1) : r * (q + 1) + (xcd - r) * q) + off; }
        const int nig = WGM * nN, gid = wgid / nig, fm = gid * WGM, gsz = (nM - fm) < WGM ? (nM - fm) : WGM;
        u.pm = fm + ((wgid % nig) % gsz); u.pn = (wgid % nig) / gsz; return true;
    }
    __device__ __forceinline__ void a_ready(const Unit&) const {}
    __device__ __forceinline__ void done(const Unit&) const {}
};
struct CountedOrder : StaticOrder {
    const unsigned* ready; unsigned need; int pm0, wid;
    __device__ __forceinline__ void a_ready(const Unit& u) const {
        if (wid == 0) {
            const unsigned* p = ready + 64 * (pm0 + u.pm); unsigned polls = 0;
            while ((unsigned)__builtin_amdgcn_readfirstlane(__hip_atomic_load(p, __ATOMIC_RELAXED, __HIP_MEMORY_SCOPE_AGENT)) < need) { __builtin_amdgcn_s_sleep(2); if (++polls > (1u << 22)) break; }
            __builtin_amdgcn_fence(__ATOMIC_ACQUIRE, "agent");
            asm volatile("s_waitcnt vmcnt(0)" ::: "memory");
        }
        asm volatile("" ::: "memory"); __builtin_amdgcn_s_barrier(); asm volatile("" ::: "memory");
    }
};
template <class Epi, class Sched>
__device__ __forceinline__ void gemm_phase(PG8_LAS unsigned char* lds, const Gemm g, const Sched& S, const Epi& E, const int wid_in) {
    const int wid = wid_in, lane = lane_id(), tid = wid * 64 + lane, wr = wid >> 2, wc = wid & 3, fr = lane & 15, fq = lane >> 4;
    const int K = g.K, nt = K / BK;
    unsigned voffA[2], voffB[2];
#pragma unroll
    for (int i = 0; i < 2; ++i) { int R, C; stage_rc(tid * 16 + i * 8192, R, C); const int Rb = Epi::PERM ? ((R & ~31) + perm32(R & 31)) : R;
        voffA[i] = (unsigned)(R * K + C) * 2u; voffB[i] = (unsigned)(Rb * K + C) * 2u; }
    const size_t kstep = (size_t)(BK * 2);
    const size_t hstep = (size_t)HALF * K * 2;
    const size_t tstep = 2 * hstep;
    const unsigned ldsw = (unsigned)wid * 1024u;
    const int aoff = lds_byte(wr * 64 + fr, fq * 8), boff = lds_byte(wc * 32 + fr, fq * 8);
#define PG8_SA(b, h) (((b) * 2 + (h)) * HTB)
#define PG8_SB(b, h) ((4 + (b) * 2 + (h)) * HTB)
#define PG8_STAGE(bufoff, gbase, voff) do { _Pragma("unroll") for (int _i = 0; _i < 2; ++_i) \
        __builtin_amdgcn_global_load_lds((const unsigned*)((const char*)(gbase) + (voff)[_i]), (PG8_LAS unsigned*)(lds + (bufoff) + ldsw + _i * 8192), 16, 0, 0); } while (0)
#define PG8_LDA(dst, b, h) do { _Pragma("unroll") for (int m = 0; m < 4; ++m) _Pragma("unroll") for (int k = 0; k < 2; ++k) dst[m][k] = *(const PG8_LAS bf16x8*)(lds + PG8_SA(b, h) + aoff + m * 2048 + k * 1024); } while (0)
#define PG8_LDB(dst, b, h) do { _Pragma("unroll") for (int n = 0; n < 2; ++n) _Pragma("unroll") for (int k = 0; k < 2; ++k) dst[n][k] = *(const PG8_LAS bf16x8*)(lds + PG8_SB(b, h) + boff + n * 2048 + k * 1024); } while (0)
#define PG8_MMA(ai, bj, At, Bt) do { __builtin_amdgcn_s_setprio(1); _Pragma("unroll") for (int m = 0; m < 4; ++m) _Pragma("unroll") for (int n = 0; n < 2; ++n) _Pragma("unroll") for (int k = 0; k < 2; ++k) \
        acc[ai][bj][m][n] = __builtin_amdgcn_mfma_f32_16x16x32_bf16(Bt[n][k], At[m][k], acc[ai][bj][m][n], 0, 0, 0); __builtin_amdgcn_s_setprio(0); } while (0)
#define PG8_WAIT_V(n) asm volatile("s_waitcnt vmcnt(" #n ")" ::: "memory")
#define PG8_WAIT_L(n) asm volatile("s_waitcnt lgkmcnt(" #n ")" ::: "memory")
#define PG8_BAR __builtin_amdgcn_s_barrier()
#define PG8_SCHED __builtin_amdgcn_sched_barrier(0)
    Unit cur, nxt; int ui = 0;
    if (!S.next(0, cur)) return;
    f32x4 acc[2][2][4][2];
#pragma unroll
    for (int a = 0; a < 2; ++a)
#pragma unroll
        for (int b = 0; b < 2; ++b)
#pragma unroll
            for (int m = 0; m < 4; ++m)
#pragma unroll
                for (int n = 0; n < 2; ++n) acc[a][b][m][n] = (f32x4){0.f, 0.f, 0.f, 0.f};
    bf16x8 At[4][2], B0[2][2], B1[2][2];
    const char* cA = (const char*)g.A + (size_t)cur.pm * tstep + (size_t)cur.br * g.a_br; const char* cB = (const char*)g.Bt + (size_t)cur.pn * tstep + (size_t)cur.br * g.b_br;
    S.a_ready(cur);
    PG8_STAGE(PG8_SB(0, 0), cB, voffB); PG8_STAGE(PG8_SA(0, 0), cA, voffA); PG8_STAGE(PG8_SB(0, 1), cB + hstep, voffB); PG8_STAGE(PG8_SA(0, 1), cA + hstep, voffA);
    if (wr == 1) PG8_BAR;
    PG8_WAIT_V(4); PG8_BAR;
    PG8_STAGE(PG8_SB(1, 0), cB + kstep, voffB); PG8_STAGE(PG8_SA(1, 0), cA + kstep, voffA); PG8_STAGE(PG8_SB(1, 1), cB + hstep + kstep, voffB);
    PG8_WAIT_V(6); PG8_BAR;
    for (;;) {
        const bool has_next = S.next(ui + 1, nxt);
        const char* nA = has_next ? (const char*)g.A + (size_t)nxt.pm * tstep + (size_t)nxt.br * g.a_br : cA; const char* nB = has_next ? (const char*)g.Bt + (size_t)nxt.pn * tstep + (size_t)nxt.br * g.b_br : cB;
        for (int t = 0; t < nt; t += 2) {
            const bool last = (t == nt - 2);
            const char* a1 = cA + (size_t)(t + 1) * kstep;
            const char* a2 = last ? nA : cA + (size_t)(t + 2) * kstep; const char* b2 = last ? nB : cB + (size_t)(t + 2) * kstep;
            const char* a3 = a2 + kstep; const char* b3 = b2 + kstep;
            if (last && has_next) S.a_ready(nxt);
            PG8_LDB(B0, 0, 0); PG8_SCHED; PG8_LDA(At, 0, 0); PG8_STAGE(PG8_SA(1, 1), a1 + hstep, voffA);
            PG8_WAIT_L(8); PG8_BAR; PG8_WAIT_L(0); PG8_MMA(0, 0, At, B0); PG8_BAR; PG8_SCHED;
            PG8_LDB(B1, 0, 1); PG8_STAGE(PG8_SB(0, 0), b2, voffB);
            PG8_BAR; PG8_WAIT_L(0); PG8_MMA(0, 1, At, B1); PG8_BAR;
            PG8_LDA(At, 0, 1); PG8_STAGE(PG8_SA(0, 0), a2, voffA);
            PG8_BAR; PG8_WAIT_L(0); PG8_MMA(1, 0, At, B0); PG8_BAR; PG8_SCHED;
            PG8_STAGE(PG8_SB(0, 1), b2 + hstep, voffB);
            PG8_WAIT_V(6); PG8_BAR; PG8_MMA(1, 1, At, B1); PG8_BAR;
            PG8_LDB(B0, 1, 0); PG8_SCHED; PG8_LDA(At, 1, 0); PG8_STAGE(PG8_SA(0, 1), a2 + hstep, voffA);
            PG8_WAIT_L(8); PG8_BAR; PG8_WAIT_L(0); PG8_MMA(0, 0, At, B0); PG8_BAR; PG8_SCHED;
            PG8_LDB(B1, 1, 1); PG8_STAGE(PG8_SB(1, 0), b3, voffB);
            PG8_BAR; PG8_WAIT_L(0); PG8_MMA(0, 1, At, B1); PG8_BAR;
            PG8_LDA(At, 1, 1); PG8_STAGE(PG8_SA(1, 0), a3, voffA);
            PG8_BAR; PG8_WAIT_L(0); PG8_MMA(1, 0, At, B0); PG8_BAR; PG8_SCHED;
            PG8_STAGE(PG8_SB(1, 1), b3 + hstep, voffB);
            PG8_WAIT_V(6); PG8_BAR; PG8_MMA(1, 1, At, B1); PG8_BAR;
        }
        if constexpr (!Epi::AFTER_DRAIN) { E(acc, cur, wr, wc, fr, fq); S.done(cur); }
        if (!has_next) break;
        if constexpr (!Epi::KEEP_ACC)
#pragma unroll
        for (int a = 0; a < 2; ++a)
#pragma unroll
            for (int b = 0; b < 2; ++b)
#pragma unroll
                for (int m = 0; m < 4; ++m)
#pragma unroll
                    for (int n = 0; n < 2; ++n) acc[a][b][m][n] = (f32x4){0.f, 0.f, 0.f, 0.f};
        cur = nxt; cA = nA; cB = nB; ++ui;
    }
    PG8_WAIT_V(0);
    if (wr == 0) PG8_BAR;
    PG8_BAR;
    if constexpr (Epi::AFTER_DRAIN) { E.fused(acc, cur, wr, wc, fr, fq, lds, wid, lane); S.done(cur); }
#undef PG8_SA
#undef PG8_SB
#undef PG8_STAGE
#undef PG8_LDA
#undef PG8_LDB
#undef PG8_MMA
#undef PG8_WAIT_V
#undef PG8_WAIT_L
#undef PG8_BAR
#undef PG8_SCHED
}
}

#define EPI_LOOP(...) \
    _Pragma("unroll") for (int ai = 0; ai < 2; ++ai) _Pragma("unroll") for (int m = 0; m < 4; ++m) { const int rl = ai * 128 + rl0 + m * 16; const int r = pm * 256 + rl; (void)r; \
    _Pragma("unroll") for (int bj = 0; bj < 2; ++bj) { const int ct = bj * 128 + cw; const f32x4 v0 = acc[ai][bj][m][0], v1 = acc[ai][bj][m][1]; __VA_ARGS__ } asm volatile("" ::: "memory"); }
#define PK8(w, a0, a1, a2, a3, a4, a5, a6, a7) u32x4 w; w.x = pk2(a0, a1); w.y = pk2(a2, a3); w.z = pk2(a4, a5); w.w = pk2(a6, a7);

DI float gate_logf(float z, float lb) { return __logf(lb + (1.f - lb) * sigmoidf_(z)); }
template <class T> DI T* at(const void* base, unsigned byteoff) { return (T*)((unsigned char*)base + byteoff); }

struct EpiIn {
    static constexpr bool PERM = true, AFTER_DRAIN = false, KEEP_ACC = false;
    unsigned char* ws; float* out; int layer; const float* lbf; const float* lbb;
    DI void operator()(const f32x4 (&acc)[2][2][4][2], const pg8::Unit& u, int wr, int wc, int, int) const {
        const int l_ = lane_id(); const int fr = l_ & 15, fq = l_ >> 4;
        const int pn = u.pn, pm = u.pm; const int rl0 = wr * 64 + fr, cw = wc * 32 + fq * 8;
        const bool prompt = pm < 32;
        if (pn < 2) {
            bf16_t* QA = (bf16_t*)(ws + O_QA);
            EPI_LOOP({ PK8(w, v0[0] * QS_NA, v0[1] * QS_NA, v0[2] * QS_NA, v0[3] * QS_NA, v1[0] * QS_NA, v1[1] * QS_NA, v1[2] * QS_NA, v1[3] * QS_NA)
                       *(u32x4*)(QA + (size_t)r * 512 + pn * 256 + ct) = w; })
        } else if (pn < 4) {
            bf16_t* KA = (bf16_t*)(ws + O_KA);
            EPI_LOOP({ PK8(w, v0[0], v0[1], v0[2], v0[3], v1[0], v1[1], v1[2], v1[3])
                       *(u32x4*)(KA + (size_t)r * 512 + (pn - 2) * 256 + ct) = w;
                       if (prompt) { float* o = out + OUT_NK + ((size_t)(pm * 2 + layer) * 256 + rl) * 512 + (pn - 2) * 256 + ct; __builtin_nontemporal_store(v0, (f32x4*)o); __builtin_nontemporal_store(v1, (f32x4*)(o + 4)); } })
        } else if (pn < 6) {
            bf16_t* VTA = (bf16_t*)(ws + O_VTA);
            EPI_LOOP({ const int c0 = (pn - 4) * 256 + ct, head = c0 >> 6, dv0 = c0 & 63;
                       bf16_t* p; size_t st;
                       if (prompt) { p = VTA + ((size_t)(pm * 8 + head) * 64 + dv0) * 256 + rl; st = 256; }
                       else { const int bs = (pm - 32) >> 3, ts = ((pm - 32) & 7) * 256 + rl; p = VTA + (size_t)4194304 + ((size_t)(bs * 8 + head) * 64 + dv0) * 2048 + ts; st = 2048; }
                       p[0] = f2bf(v0[0]); p[st] = f2bf(v0[1]); p[2 * st] = f2bf(v0[2]); p[3 * st] = f2bf(v0[3]);
                       p[4 * st] = f2bf(v1[0]); p[5 * st] = f2bf(v1[1]); p[6 * st] = f2bf(v1[2]); p[7 * st] = f2bf(v1[3]);
                       if (prompt) { float* o = out + OUT_NV + ((size_t)(pm * 2 + layer) * 256 + rl) * 512 + c0; __builtin_nontemporal_store(v0, (f32x4*)o); __builtin_nontemporal_store(v1, (f32x4*)(o + 4)); } })
        } else if (pn < 8) {
            bf16_t* G = (bf16_t*)(ws + O_GNA);
            EPI_LOOP({ PK8(w, siluf_(v0[0]), siluf_(v0[1]), siluf_(v0[2]), siluf_(v0[3]), siluf_(v1[0]), siluf_(v1[1]), siluf_(v1[2]), siluf_(v1[3]))
                       *(u32x4*)(G + (size_t)r * 512 + (pn - 6) * 256 + ct) = w; })
        } else if (pn < 11) {
            bf16_t* CQ = (bf16_t*)(ws + O_CQ); bf16_t* CKVB = (bf16_t*)(ws + O_CKVB); float* CKVF = (float*)(ws + O_CKVF);
            float* CQSS = (float*)(ws + O_CQSS); float* CKVSS = (float*)(ws + O_CKVSS);
#pragma unroll
            for (int ai = 0; ai < 2; ++ai)
#pragma unroll
                for (int m = 0; m < 4; ++m) {
                    const int rl = ai * 128 + rl0 + m * 16; const int r = pm * 256 + rl; float s = 0.f;
#pragma unroll
                    for (int bj = 0; bj < 2; ++bj) {
                        const int ct = bj * 128 + cw; const f32x4 v0 = acc[ai][bj][m][0], v1 = acc[ai][bj][m][1];
                        s += (v0[0] * v0[0] + v0[1] * v0[1]) + (v0[2] * v0[2] + v0[3] * v0[3]) + (v1[0] * v1[0] + v1[1] * v1[1]) + (v1[2] * v1[2] + v1[3] * v1[3]);
                        PK8(w, v0[0], v0[1], v0[2], v0[3], v1[0], v1[1], v1[2], v1[3])
                        if (pn < 10) *(u32x4*)(CQ + (size_t)r * 512 + (pn - 8) * 256 + ct) = w;
                        else { *(u32x4*)(CKVB + (size_t)r * 256 + ct) = w; if (prompt) { float* o = CKVF + (size_t)r * 256 + ct; *(f32x4*)o = v0; *(f32x4*)(o + 4) = v1; } }
                    }
                    s += xor_swz<16>(s); s = sum_x32(s);
                    if (fq == 0) { if (pn < 10) CQSS[(size_t)r * 8 + (pn - 8) * 4 + wc] = s; else CKVSS[(size_t)r * 4 + wc] = s; }
                }
        } else if (pn < 13) {
            bf16_t* G = (bf16_t*)(ws + O_GMLA);
            EPI_LOOP({ PK8(w, siluf_(v0[0]), siluf_(v0[1]), siluf_(v0[2]), siluf_(v0[3]), siluf_(v1[0]), siluf_(v1[1]), siluf_(v1[2]), siluf_(v1[3]))
                       *(u32x4*)(G + (size_t)r * 512 + (pn - 11) * 256 + ct) = w; })
        } else if (pn < 15) {
            float* HQ = (float*)(ws + O_HQ);
            EPI_LOOP({ float* o = HQ + (size_t)r * 512 + (pn - 13) * 256 + ct;
                       *(f32x4*)o = (f32x4){siluf_(v0[0]), siluf_(v0[1]), siluf_(v0[2]), siluf_(v0[3])}; *(f32x4*)(o + 4) = (f32x4){siluf_(v1[0]), siluf_(v1[1]), siluf_(v1[2]), siluf_(v1[3])}; })
        } else if (pn < 19) {
            const bool fwd = pn < 17; const int pb = fwd ? 15 : 17;
            float* LF = (float*)(ws + (fwd ? O_LFF : O_LFB)); const float* lbp = fwd ? lbf : lbb; const bool has_lb = layer > 0;
            float lbv[2][8];
#pragma unroll
            for (int bj = 0; bj < 2; ++bj)
#pragma unroll
                for (int e = 0; e < 8; ++e) { const int col = (pn - pb) * 256 + bj * 128 + cw + e; lbv[bj][e] = has_lb ? sigmoidf_(lbp[512 + col] - lbp[col]) : 0.f; }
            EPI_LOOP({ float* o = LF + (size_t)r * 512 + (pn - pb) * 256 + ct;
                       *(f32x4*)o = (f32x4){gate_logf(v0[0], lbv[bj][0]), gate_logf(v0[1], lbv[bj][1]), gate_logf(v0[2], lbv[bj][2]), gate_logf(v0[3], lbv[bj][3])};
                       *(f32x4*)(o + 4) = (f32x4){gate_logf(v1[0], lbv[bj][4]), gate_logf(v1[1], lbv[bj][5]), gate_logf(v1[2], lbv[bj][6]), gate_logf(v1[3], lbv[bj][7])}; })
        } else if (pn < 21) {
            float* HV = (float*)(ws + O_HV);
            EPI_LOOP({ float* o = HV + (size_t)r * 512 + (pn - 19) * 256 + ct; *(f32x4*)o = v0; *(f32x4*)(o + 4) = v1; })
        } else if (pn < 23) {
            bf16_t* G = (bf16_t*)(ws + O_GHG);
            EPI_LOOP({ PK8(w, siluf_(v0[0]), siluf_(v0[1]), siluf_(v0[2]), siluf_(v0[3]), siluf_(v1[0]), siluf_(v1[1]), siluf_(v1[2]), siluf_(v1[3]))
                       *(u32x4*)(G + (size_t)r * 512 + (pn - 21) * 256 + ct) = w; })
        } else if (pn < 47) {
            EPI_LOOP({ const f32x4 s0 = (f32x4){sigmoidf_(v0[0]), sigmoidf_(v0[1]), sigmoidf_(v0[2]), sigmoidf_(v0[3])} * 255.f + 0.5f, s1 = (f32x4){sigmoidf_(v1[0]), sigmoidf_(v1[1]), sigmoidf_(v1[2]), sigmoidf_(v1[3])} * 255.f + 0.5f;
                       u32x2 w; w.x = max((unsigned)s0[0], 1u) | (max((unsigned)s0[1], 1u) << 8) | (max((unsigned)s0[2], 1u) << 16) | (max((unsigned)s0[3], 1u) << 24);
                       w.y = max((unsigned)s1[0], 1u) | (max((unsigned)s1[1], 1u) << 8) | (max((unsigned)s1[2], 1u) << 16) | (max((unsigned)s1[3], 1u) << 24);
                       *at<u32x2>(ws, (unsigned)O_SIG + (unsigned)(r * 6144 + (pn - 23) * 256 + ct)) = w; })
        } else {
            float* KRF = (float*)(ws + O_KRF);
            if (wc == 0) {
                EPI_LOOP({ if (bj == 0) { float* o = KRF + (size_t)r * 32 + ct; *(f32x4*)o = v0; *(f32x4*)(o + 4) = v1; } })
            }
        }
    }
};

struct EpiUQ {
    static constexpr bool PERM = true, AFTER_DRAIN = false, KEEP_ACC = false;
    unsigned char* ws;
    DI void operator()(const f32x4 (&acc)[2][2][4][2], const pg8::Unit& u, int wr, int wc, int, int) const {
        const int l_ = lane_id(); const int fr = l_ & 15, fq = l_ >> 4;
        const int pn = u.pn, pm = u.pm; const int rl0 = wr * 64 + fr, cw = wc * 32 + fq * 8;
        const float* CQSS = (const float*)(ws + O_CQSS); const float* ROPE = (const float*)(ws + O_ROPE); bf16_t* QM = (bf16_t*)(ws + O_QM);
        const bool sample = pm >= 32;
#pragma unroll
        for (int ai = 0; ai < 2; ++ai)
#pragma unroll
            for (int m = 0; m < 4; ++m) {
                const int rl = ai * 128 + rl0 + m * 16; const int r = pm * 256 + rl;
                const f32x4 sa = *(const f32x4*)(CQSS + (size_t)r * 8), sb = *(const f32x4*)(CQSS + (size_t)r * 8 + 4);
                const float rs = rsqrtf(((sa[0] + sa[1]) + (sa[2] + sa[3]) + (sb[0] + sb[1]) + (sb[2] + sb[3])) * (1.f / 512.f) + EPS) * QS_MLA;
#pragma unroll
                for (int bj = 0; bj < 2; ++bj) {
                    const int ct = bj * 128 + cw; const f32x4 v0 = acc[ai][bj][m][0], v1 = acc[ai][bj][m][1];
                    float x[8] = {v0[0] * rs, v0[1] * rs, v0[2] * rs, v0[3] * rs, v1[0] * rs, v1[1] * rs, v1[2] * rs, v1[3] * rs};
                    const int gid = pn * 8 + bj * 4 + wc;
                    if (sample && (gid % 3 == 2)) {
                        const int ts = ((pm - 32) & 7) * 256 + rl; const int pos = (fq >> 1) ? (ts & 63) : (ts >> 6); const bool half = fq & 1;
                        const float* tb = ROPE + pos * 16;
                        const f32x4 t0 = *(const f32x4*)tb, t1 = *(const f32x4*)(tb + 4), t2 = *(const f32x4*)(tb + 8), t3 = *(const f32x4*)(tb + 12);
                        const float cs[8] = {t0[0], t0[2], t1[0], t1[2], t2[0], t2[2], t3[0], t3[2]}, sn[8] = {t0[1], t0[3], t1[1], t1[3], t2[1], t2[3], t3[1], t3[3]};
#pragma unroll
                        for (int e = 0; e < 8; ++e) { const float pr = xor_swz<16>(x[e]); x[e] = x[e] * cs[e] + (half ? pr : -pr) * sn[e]; }
                    }
                    PK8(w, x[0], x[1], x[2], x[3], x[4], x[5], x[6], x[7])
                    *(u32x4*)(QM + (size_t)r * 768 + pn * 256 + ct) = w;
                }
            }
    }
};

struct EpiKV {
    static constexpr bool PERM = true, AFTER_DRAIN = false, KEEP_ACC = false;
    unsigned char* ws; int layer; int ctx;
    DI void operator()(const f32x4 (&acc)[2][2][4][2], const pg8::Unit& u, int wr, int wc, int, int) const {
        const int l_ = lane_id(); const int fr = l_ & 15, fq = l_ >> 4;
        const int pn = u.pn, pm = u.pm; const int rl0 = wr * 64 + fr, fq8 = fq * 8;
        unsigned kbase, vbase; int vst;
        if (ctx) { const int b = pm >> 1, t0 = (pm & 1) * 256; kbase = (unsigned)O_KNS + (unsigned)(((layer * 2 + b) * 2560 + t0) * 1024); vbase = (unsigned)O_VTMS + (unsigned)(((layer * 2 + b) * 8 * 64 * 2560 + t0) * 2); vst = 2560; }
        else if (pm < 32) { kbase = (unsigned)O_KNP + (unsigned)(pm * 256 * 1024); vbase = (unsigned)O_VTMP + (unsigned)(pm * 8 * 64 * 256 * 2); vst = 256; }
        else { const int bs = (pm - 32) >> 3, t0 = 512 + ((pm - 32) & 7) * 256; kbase = (unsigned)O_KNS + (unsigned)(((layer * 2 + bs) * 2560 + t0) * 1024); vbase = (unsigned)O_VTMS + (unsigned)(((layer * 2 + bs) * 8 * 64 * 2560 + t0) * 2); vst = 2560; }
#pragma unroll
        for (int ai = 0; ai < 2; ++ai)
#pragma unroll
            for (int m = 0; m < 4; ++m) {
                const int rl = ai * 128 + rl0 + m * 16;
                float rs = 1.f;
                if (!ctx) { const f32x4 sa = *at<const f32x4>(ws, (unsigned)O_CKVSS + (unsigned)((pm * 256 + rl) * 16)); rs = rsqrtf(((sa[0] + sa[1]) + (sa[2] + sa[3])) * (1.f / 256.f) + EPS); }
#pragma unroll
                for (int bj = 0; bj < 2; ++bj) {
                    const f32x4 v0 = acc[ai][bj][m][0] * rs, v1 = acc[ai][bj][m][1] * rs;
                    const int gid = pn * 8 + bj * 4 + wc, head = gid >> 2, part = gid & 3;
                    if (part < 2) { PK8(w, v0[0], v0[1], v0[2], v0[3], v1[0], v1[1], v1[2], v1[3]) *at<u32x4>(ws, kbase + (unsigned)(rl * 1024 + (head * 64 + part * 32 + fq8) * 2)) = w; }
                    else { const unsigned sb = (unsigned)(vst * 2); unsigned o = vbase + (unsigned)(rl * 2) + (unsigned)(head * 64 + (part - 2) * 32 + fq8) * sb;
                        *at<bf16_t>(ws, o) = f2bf(v0[0]); *at<bf16_t>(ws, o + sb) = f2bf(v0[1]); *at<bf16_t>(ws, o + 2 * sb) = f2bf(v0[2]); *at<bf16_t>(ws, o + 3 * sb) = f2bf(v0[3]);
                        *at<bf16_t>(ws, o + 4 * sb) = f2bf(v1[0]); *at<bf16_t>(ws, o + 5 * sb) = f2bf(v1[1]); *at<bf16_t>(ws, o + 6 * sb) = f2bf(v1[2]); *at<bf16_t>(ws, o + 7 * sb) = f2bf(v1[3]); }
                }
                asm volatile("" ::: "memory");
            }
    }
};

DI f32x4 ub4(unsigned w) { return (f32x4){(float)(w & 255u), (float)((w >> 8) & 255u), (float)((w >> 16) & 255u), (float)(w >> 24)}; }
struct EpiMerge {
    static constexpr bool PERM = true, AFTER_DRAIN = false, KEEP_ACC = true;
    unsigned char* ws; int pm0; unsigned* cnt;
    DI void operator()(f32x4 (&acc)[2][2][4][2], const pg8::Unit& u, int wr, int wc, int, int) const {
        const int l_ = lane_id(); const int fr = l_ & 15, fq = l_ >> 4;
        const int pn = u.pn, pm = u.pm + pm0, br = u.br; const int rl0 = wr * 64 + fr, cw = wc * 32 + fq * 8;
        const unsigned sbase = (unsigned)O_SIG + (unsigned)((pm * 256 + rl0) * 6144 + br * 2048 + pn * 256 + cw);
        const unsigned mbase = (unsigned)O_MERGED + (unsigned)((pm * 256 + rl0) * 4096 + (pn * 256 + cw) * 2);
        u32x2 sg[2][4][2], sn[2][4][2];
#pragma unroll
        for (int ai = 0; ai < 2; ++ai)
#pragma unroll
            for (int m = 0; m < 4; ++m)
#pragma unroll
                for (int bj = 0; bj < 2; ++bj) {
                    sg[ai][m][bj] = *at<const u32x2>(ws, sbase + (unsigned)((ai * 128 + m * 16) * 6144 + bj * 128));
                    if (br < 2) sn[ai][m][bj] = *at<const u32x2>(ws, sbase + (unsigned)((ai * 128 + m * 16) * 6144 + bj * 128 + 2048));
                    else sn[ai][m][bj] = (u32x2){0x01010101u, 0x01010101u};
                }
#pragma unroll
        for (int ai = 0; ai < 2; ++ai)
#pragma unroll
            for (int m = 0; m < 4; ++m)
#pragma unroll
                for (int bj = 0; bj < 2; ++bj) {
                    const u32x2 s2 = sg[ai][m][bj], n2 = sn[ai][m][bj];
                    const f32x4 a = ub4(s2.x) * acc[ai][bj][m][0], b = ub4(s2.y) * acc[ai][bj][m][1];
                    if (br < 2) {
                        const f32x4 na = ub4(n2.x), nb = ub4(n2.y);
                        acc[ai][bj][m][0] = a * (f32x4){__builtin_amdgcn_rcpf(na[0]), __builtin_amdgcn_rcpf(na[1]), __builtin_amdgcn_rcpf(na[2]), __builtin_amdgcn_rcpf(na[3])};
                        acc[ai][bj][m][1] = b * (f32x4){__builtin_amdgcn_rcpf(nb[0]), __builtin_amdgcn_rcpf(nb[1]), __builtin_amdgcn_rcpf(nb[2]), __builtin_amdgcn_rcpf(nb[3])};
                    } else {
                        const f32x4 a1 = a * (1.f / 255.f), b1 = b * (1.f / 255.f);
                        PK8(w, a1[0], a1[1], a1[2], a1[3], b1[0], b1[1], b1[2], b1[3])
                        { u32x4* mp_ = at<u32x4>(ws, mbase + (unsigned)((ai * 128 + m * 16) * 4096 + bj * 256)); asm volatile("global_store_dwordx4 %0, %1, off sc0 sc1" :: "v"(mp_), "v"(w) : "memory"); }
                        acc[ai][bj][m][0] = (f32x4){0.f, 0.f, 0.f, 0.f}; acc[ai][bj][m][1] = (f32x4){0.f, 0.f, 0.f, 0.f};
                    }
                }
        if (br == 2) {
            asm volatile("s_waitcnt vmcnt(0)" ::: "memory");
            if (l_ == 0) __hip_atomic_fetch_add(cnt + 64 * pm, 1u, __ATOMIC_RELAXED, __HIP_MEMORY_SCOPE_AGENT);
        }
    }
};

struct EpiOut {
    static constexpr bool PERM = true, AFTER_DRAIN = false, KEEP_ACC = false;
    unsigned char* ws; int pm0;
    DI void operator()(const f32x4 (&acc)[2][2][4][2], const pg8::Unit& u, int wr, int wc, int, int) const {
        const int l_ = lane_id(); const int fr = l_ & 15, fq = l_ >> 4;
        const int pn = u.pn, pm = u.pm + pm0; const int rl0 = wr * 64 + fr, cw = wc * 32 + fq * 8;
        bf16_t* OB = (bf16_t*)(ws + O_OUTB); float* OSS = (float*)(ws + O_OSS);
#pragma unroll
        for (int ai = 0; ai < 2; ++ai)
#pragma unroll
            for (int m = 0; m < 4; ++m) {
                const int rl = ai * 128 + rl0 + m * 16; const int r = pm * 256 + rl; float s = 0.f;
#pragma unroll
                for (int bj = 0; bj < 2; ++bj) {
                    const int ct = bj * 128 + cw; const f32x4 v0 = acc[ai][bj][m][0], v1 = acc[ai][bj][m][1];
                    s += (v0[0] * v0[0] + v0[1] * v0[1]) + (v0[2] * v0[2] + v0[3] * v0[3]) + (v1[0] * v1[0] + v1[1] * v1[1]) + (v1[2] * v1[2] + v1[3] * v1[3]);
                    PK8(w, v0[0], v0[1], v0[2], v0[3], v1[0], v1[1], v1[2], v1[3])
                    *(u32x4*)(OB + (size_t)r * 2048 + pn * 256 + ct) = w;
                }
                s += xor_swz<16>(s); s = sum_x32(s);
                if (fq == 0) OSS[(size_t)r * 32 + pn * 4 + wc] = s;
            }
    }
};

constexpr int LDS_BYTES = 147456;
constexpr int KSTR = 208, VSTR = 144;
constexpr int A_K0 = 0, A_K1 = 64 * KSTR, A_V0 = 2 * 64 * KSTR, A_V1 = A_V0 + 64 * VSTR, A_MRG = A_V0 + 2 * 64 * VSTR;
static_assert(A_MRG + 4 * 34 * 64 * 4 <= 98304, "attention LDS map");
constexpr int HG_SCR = 98304;

constexpr int GV_SV = 73728, GV_PART = GV_SV + 3 * 2048 * 4;
static_assert(GV_PART + 8 * 3 * 256 * 4 <= LDS_BYTES, "gemv LDS map");
#define LDSW() asm volatile("s_waitcnt lgkmcnt(0)" ::: "memory")
#define MFMA32(a, b, c) __builtin_amdgcn_mfma_f32_32x32x16_bf16((a), (b), (c), 0, 0, 0)

constexpr int LDS_BAR = LDS_BYTES - 64;
#define XB_TMO      128
#define XB_XCNT(j)  (256  + 64 * (j))
#define XB_XSUB(j)  (1280 + 64 * (j))
#define XB_XGEN(j)  (2304 + 64 * (j))
#define XB_TOP      3328
#define XB_TOPGEN   3392
#define XCD_BAR_WORDS 3456
#define XB_SPIN_CAP (1u << 18)

__device__ __forceinline__ unsigned xb_ld(unsigned* p)              { return __hip_atomic_load(p, __ATOMIC_RELAXED, __HIP_MEMORY_SCOPE_AGENT); }
__device__ __forceinline__ unsigned xb_add(unsigned* p, unsigned v) { return __hip_atomic_fetch_add(p, v, __ATOMIC_RELAXED, __HIP_MEMORY_SCOPE_AGENT); }
__device__ __forceinline__ unsigned xb_xcc_id() { return (unsigned)__builtin_amdgcn_s_getreg((3 << 11) | 20) & 0xFu; }
#define XB_SPIN(cond, bar) do { unsigned _sp = 0; while (cond) { __builtin_amdgcn_s_sleep(1); \
    if ((++_sp & 255u) == 0u) { if (xb_ld(&(bar)[XB_TMO])) break; if (_sp > XB_SPIN_CAP) { atomicAdd(&(bar)[XB_TMO], 1u); break; } } } } while (0)

struct XcdBarrier {
    unsigned* bar; unsigned x;
    volatile LAS unsigned* st;
};

__device__ __forceinline__ XcdBarrier xcd_barrier_post(unsigned* bar, volatile LAS unsigned* st) {
    XcdBarrier b; b.bar = bar; b.x = xb_xcc_id(); b.st = st;
    if (threadIdx.x == 0) (void)xb_add(&bar[XB_XCNT(b.x)], 1u);
    return b;
}
__device__ __forceinline__ void xcd_barrier_complete(unsigned* bar, unsigned x, unsigned& nloc, unsigned& nx) {
    const unsigned G = gridDim.x * gridDim.y * gridDim.z;
    unsigned sum, cnt, mine, sp = 0u;
    for (;;) {
        sum = 0u; cnt = 0u; mine = 0u;
#pragma unroll
        for (unsigned j = 0; j < 16; ++j) { const unsigned c = xb_ld(&bar[XB_XCNT(j)]); sum += c; cnt += (c > 0u) ? 1u : 0u; mine = (j == x) ? c : mine; }
        if (sum == G) break;
        __builtin_amdgcn_s_sleep(1);
        if ((++sp & 255u) == 0u) { if (xb_ld(&bar[XB_TMO])) break; if (sp > XB_SPIN_CAP) { atomicAdd(&bar[XB_TMO], 1u); break; } }
    }
    nloc = mine > 0u ? mine : 1u; nx = cnt > 0u ? cnt : 1u;
}

__device__ __forceinline__ void xcd_barrier(const XcdBarrier& b) {
    asm volatile("s_waitcnt vmcnt(0)" ::: "memory");
    __syncthreads();
    if (threadIdx.x == 0) {
        unsigned* bar = b.bar;
        __builtin_amdgcn_s_waitcnt(0);
        unsigned nloc = b.st[0], nx = b.st[1];
        if (nloc == 0u) { xcd_barrier_complete(bar, b.x, nloc, nx); b.st[0] = nloc; b.st[1] = nx; }
        const unsigned old = xb_add(&bar[XB_XSUB(b.x)], 1u);
        const unsigned gen = old / nloc;
        if (old + 1u == (gen + 1u) * nloc) {
            __builtin_amdgcn_fence(__ATOMIC_RELEASE, "agent");
            asm volatile("s_waitcnt vmcnt(0)" ::: "memory");
            const unsigned og = xb_add(&bar[XB_TOP], 1u);
            const unsigned tg = og / nx;
            if (og + 1u == (tg + 1u) * nx) xb_add(&bar[XB_TOPGEN], 1u);
            else XB_SPIN(xb_ld(&bar[XB_TOPGEN]) == tg, bar);
            __builtin_amdgcn_fence(__ATOMIC_ACQUIRE, "agent");
            xb_add(&bar[XB_XGEN(b.x)], 1u);
            asm volatile("s_waitcnt vmcnt(0)" ::: "memory");
        } else {
            XB_SPIN(xb_ld(&bar[XB_XGEN(b.x)]) == gen, bar);
            __builtin_amdgcn_fence(__ATOMIC_ACQUIRE, "agent");
            asm volatile("s_waitcnt vmcnt(0)" ::: "memory");
        }
    }
    __syncthreads();
}

DI void transpose_item(const float* W, int ldw, int n0src, int k0, bf16_t* WT, int ldt, int nrow0, const float* kscale, LAS float* scr, int lane) {
    float v[32];
#pragma unroll
    for (int i = 0; i < 32; ++i) { const int kk = 2 * i + (lane >> 5); v[i] = n0src >= 0 ? W[(size_t)(k0 + kk) * ldw + n0src + (lane & 31)] : 0.f; }
    if (kscale) {
#pragma unroll
        for (int i = 0; i < 32; ++i) v[i] *= kscale[k0 + 2 * i + (lane >> 5)];
    }
#pragma unroll
    for (int i = 0; i < 32; ++i) scr[(2 * i + (lane >> 5)) * 33 + (lane & 31)] = v[i];
    LDSW();
    const int c = lane & 7;
#pragma unroll
    for (int j = 0; j < 4; ++j) { const int n = (lane >> 3) + 8 * j; const LAS float* s = scr + (8 * c) * 33 + n;
        u32x4 o; o.x = pk2(s[0 * 33], s[1 * 33]); o.y = pk2(s[2 * 33], s[3 * 33]); o.z = pk2(s[4 * 33], s[5 * 33]); o.w = pk2(s[6 * 33], s[7 * 33]);
        *(u32x4*)(WT + (size_t)(nrow0 + n) * ldt + k0 + 8 * c) = o; }
    LDSW();
}

DI void setup_transposes(const Params& P, LAS unsigned char* lds, int gw, int ngw, int wid, int lane) {
    LAS float* scr = (LAS float*)(lds + wid * 8704);
    unsigned char* ws = P.ws;
    constexpr int I_IN = 32 * 384, I_OUT = 32 * 64, I_BR = 8 * 64, I_UQ = 8 * 24, I_UKV = 4 * 32;
    constexpr int PER_LAYER = I_IN + I_OUT + 3 * I_BR + I_UQ + 2 * I_UKV;
    for (int it = gw; it < 2 * PER_LAYER; it += ngw) {
        const int l = it / PER_LAYER; int r = it - l * PER_LAYER;
        if (r < I_IN) {
            const int kb = r / 384, nb = r % 384, n0 = nb * 32;
            const int src = n0 < 2816 ? n0 : (n0 < 12032 ? n0 + 32 : (n0 < 12064 ? n0 - 12032 + 2816 : -1));
            transpose_item(P.in[I_WIN] + (size_t)l * DM * PROJ_ORIG, PROJ_ORIG, src, kb * 64, (bf16_t*)(ws + O_WIN) + (size_t)l * NPROJ * DM, DM, n0, nullptr, scr, lane); continue; }
        r -= I_IN;
        if (r < I_OUT) { const int kb = r / 64, nb = r % 64;
            transpose_item(P.in[I_WOUT] + (size_t)l * DM * DM, DM, nb * 32, kb * 64, (bf16_t*)(ws + O_WOUT) + (size_t)l * DM * DM, DM, nb * 32, nullptr, scr, lane); continue; }
        r -= I_OUT;
        if (r < 3 * I_BR) { const int br = r / I_BR, q = r % I_BR, kb = q / 64, nb = q % 64;
            transpose_item(P.in[I_WBNA + br] + (size_t)l * 512 * DM, DM, nb * 32, kb * 64, (bf16_t*)(ws + O_WBR) + (size_t)(l * 3 + br) * DM * 512, 512, nb * 32, nullptr, scr, lane); continue; }
        r -= 3 * I_BR;
        if (r < I_UQ) { const int kb = r / 24, nb = r % 24;
            transpose_item(P.in[I_WUQ] + (size_t)l * 512 * 768, 768, nb * 32, kb * 64, (bf16_t*)(ws + O_WUQ) + (size_t)l * 768 * 512, 512, nb * 32, P.in[I_GMQ] + l * 512, scr, lane); continue; }
        r -= I_UQ;
        { const int var = r / I_UKV, q = r % I_UKV, kb = q / 32, nb = q % 32;
            transpose_item(P.in[I_WUKV] + (size_t)l * 256 * 1024, 1024, nb * 32, kb * 64, (bf16_t*)(ws + (var ? O_WUKVG : O_WUKV)) + (size_t)l * 1024 * 256, 256, nb * 32,
                           var ? P.in[I_GMKV] + l * 256 : nullptr, scr, lane); }
    }
}

DI void win1_transposes(const Params& P, LAS unsigned char* lds, int gw, int ngw, int wid, int lane) {
    LAS float* scr = (LAS float*)(lds + wid * 8704);
    const float* W = P.in[I_WIN] + (size_t)DM * PROJ_ORIG; bf16_t* WT = (bf16_t*)(P.ws + O_WIN) + (size_t)NPROJ * DM;
#pragma unroll 1
    for (int r = gw; r < 32 * 384; r += ngw) {
        const int kb = r / 384, nb = r % 384, n0 = nb * 32;
        const int src = n0 < 2816 ? n0 : (n0 < 12032 ? n0 + 32 : (n0 < 12064 ? n0 - 12032 + 2816 : -1));
        transpose_item(W, PROJ_ORIG, src, kb * 64, WT, DM, n0, nullptr, scr, lane);
    }
}

DI void setup_gemv(const Params& P, LAS unsigned char* lds, int job, int tid, int wid, int lane) {
    const int l = job / 96, col0 = (job % 96) * 64;
    LAS float* sv = (LAS float*)(lds + GV_SV); LAS float* part = (LAS float*)(lds + GV_PART);
    for (int i = tid; i < 3 * 2048; i += 512) { const int vec = i >> 11, k = i & 2047; const float x = vec == 0 ? P.in[I_CCTX][k] : P.in[I_C][(vec - 1) * 2048 + k]; sv[i] = x / (1.f + expf(-x)); }
    __syncthreads();
    const int rg = lane >> 4, c4 = lane & 15;
    const float* W = P.in[I_WADA] + (size_t)l * DM * 6144 + col0 + 4 * c4;
    f32x4 a0 = {0.f, 0.f, 0.f, 0.f}, a1 = a0, a2 = a0;
#pragma unroll 8
    for (int it = 0; it < 64; ++it) { const int k = wid * 256 + 4 * it + rg; const f32x4 w = *(const f32x4*)(W + (size_t)k * 6144); a0 += w * sv[k]; a1 += w * sv[2048 + k]; a2 += w * sv[4096 + k]; }
#pragma unroll
    for (int e = 0; e < 4; ++e) {
        a0[e] += xor_swz<16>(a0[e]); a0[e] = sum_x32(a0[e]);
        a1[e] += xor_swz<16>(a1[e]); a1[e] = sum_x32(a1[e]);
        a2[e] += xor_swz<16>(a2[e]); a2[e] = sum_x32(a2[e]);
    }
    if (lane < 16) { *(LAS f32x4*)(part + (wid * 3 + 0) * 64 + 4 * c4) = a0; *(LAS f32x4*)(part + (wid * 3 + 1) * 64 + 4 * c4) = a1; *(LAS f32x4*)(part + (wid * 3 + 2) * 64 + 4 * c4) = a2; }
    __syncthreads();
    if (tid < 192) {
        const int vec = tid >> 6, c = tid & 63; float* MOD = (float*)(P.ws + O_MOD);
        float s = P.in[I_BADA][l * 6144 + col0 + c];
#pragma unroll
        for (int w = 0; w < 8; ++w) s += part[(w * 3 + vec) * 64 + c];
        MOD[(size_t)(l * 3 + vec) * 6144 + col0 + c] = s;
    }
    __syncthreads();
}

DI void setup_convert(const Params& P, int gtid, int ngt) {
    unsigned char* ws = P.ws;
    bf16_t* CKA = (bf16_t*)(ws + O_CKA); bf16_t* CVTA = (bf16_t*)(ws + O_CVTA); bf16_t* CCKV = (bf16_t*)(ws + O_CCKV); bf16_t* KRS = (bf16_t*)(ws + O_KRS); float* ROPE = (float*)(ws + O_ROPE);
    constexpr int NA = 1048576, NB = 1048576, NC = 524288, ND = 65536, NE = 512;
    for (int i = gtid; i < NA + NB + NC + ND + NE; i += ngt) {
        int x = i;
        if (x < NA) { const int c = x & 511, t = (x >> 9) & 511, b = (x >> 18) & 1, l = x >> 19; CKA[x] = f2bf(P.in[I_CNK][((size_t)(b * 2 + l) * 512 + t) * 512 + c]); continue; }
        x -= NA;
        if (x < NB) { const int t = x & 511, dv = (x >> 9) & 63, hd = (x >> 15) & 7, b = (x >> 18) & 1, l = x >> 19; CVTA[x] = f2bf(P.in[I_CNV][((size_t)(b * 2 + l) * 512 + t) * 512 + hd * 64 + dv]); continue; }
        x -= NB;
        if (x < NC) { const int c = x & 255, t = (x >> 8) & 511, b = (x >> 17) & 1, l = x >> 18; CCKV[x] = f2bf(P.in[I_CCKV][((size_t)(b * 2 + l) * 512 + t) * 256 + c]); continue; }
        x -= NC;
        if (x < ND) { const int d = x & 31, t = (x >> 5) & 511, b = (x >> 14) & 1, l = x >> 15; KRS[((size_t)(l * 2 + b) * 2560 + t) * 32 + d] = f2bf(P.in[I_CKR][((size_t)(b * 2 + l) * 512 + t) * 32 + d]); continue; }
        x -= ND;
        { const int fi = x & 7, pos = x >> 3; const float inv = powf(10000.f, -(float)fi / 8.f), ang = (float)pos * inv; ROPE[x * 2] = cosf(ang); ROPE[x * 2 + 1] = sinf(ang); }
    }
}

DI void prenorm_store(const f32x4 (&y)[8], float ss, const float* gpre, const float* mod, bf16_t* hrow, int lane) {
    const float rstd = rsqrtf(ss * (1.f / 2048.f) + EPS);
#pragma unroll
    for (int j = 0; j < 8; ++j) { const int c = 4 * lane + 256 * j;
        const f32x4 g = *(const f32x4*)(gpre + c), sh = *(const f32x4*)(mod + c), sc = *(const f32x4*)(mod + 2048 + c);
        const f32x4 hh = y[j] * rstd * g * (sc + 1.f) + sh;
        u32x2 w; w.x = pk2(hh[0], hh[1]); w.y = pk2(hh[2], hh[3]); *(u32x2*)(hrow + c) = w; }
}
DI void prenorm_layer0(const Params& P, int gw, int ngw, int lane) {
    const float* MOD = (const float*)(P.ws + O_MOD); bf16_t* H = (bf16_t*)(P.ws + O_H);
    for (int r = gw; r < NTOK; r += ngw) {
        const float* xr = r < NPR ? P.in[I_XP] + (size_t)r * DM : P.in[I_XS] + (size_t)(r - NPR) * DM; const int vec = r < NPR ? 0 : 1 + ((r - NPR) >> 11);
        f32x4 y[8]; float ss = 0.f;
#pragma unroll
        for (int j = 0; j < 8; ++j) { y[j] = *(const f32x4*)(xr + 4 * lane + 256 * j); ss += (y[j][0] * y[j][0] + y[j][1] * y[j][1]) + (y[j][2] * y[j][2] + y[j][3] * y[j][3]); }
        ss = wave_sum(ss);
        prenorm_store(y, ss, P.in[I_GPRE], MOD + (size_t)vec * 6144, H + (size_t)r * DM, lane);
    }
}
DI void postnorm_phase(const Params& P, int layer, int gw, int ngw, int lane) {
    OPAQUE_V(lane);
    const float* MOD = (const float*)(P.ws + O_MOD); bf16_t* H = (bf16_t*)(P.ws + O_H); const bf16_t* OB = (const bf16_t*)(P.ws + O_OUTB); const float* OSS = (const float*)(P.ws + O_OSS);
    for (int r = gw; r < NTOK; r += ngw) {
        const int vec = r < NPR ? 0 : 1 + ((r - NPR) >> 11);
        float* yr = r < NPR ? P.out + OUT_YP + (size_t)r * DM : P.out + OUT_YS + (size_t)(r - NPR) * DM;
        const float* xr = layer == 0 ? (r < NPR ? P.in[I_XP] + (size_t)r * DM : P.in[I_XS] + (size_t)(r - NPR) * DM) : yr;
        float so = lane < 32 ? OSS[(size_t)r * 32 + lane] : 0.f; so = wave_sum(so);
        const float rstd = rsqrtf(so * (1.f / 2048.f) + EPS);
        const float* mod = MOD + (size_t)(layer * 3 + vec) * 6144; const float* gp = P.in[I_GPOST] + layer * DM;
        f32x4 y[8]; float ss = 0.f;
#pragma unroll
        for (int j = 0; j < 8; ++j) { const int c = 4 * lane + 256 * j;
            const f32x4 x = *(const f32x4*)(xr + c), gt = *(const f32x4*)(mod + 4096 + c), g = *(const f32x4*)(gp + c); const u32x2 ob = *(const u32x2*)(OB + (size_t)r * DM + c);
            const f32x4 o = {bflo(ob.x), bfhi(ob.x), bflo(ob.y), bfhi(ob.y)};
            y[j] = x + gt * (o * rstd * g); ss += (y[j][0] * y[j][0] + y[j][1] * y[j][1]) + (y[j][2] * y[j][2] + y[j][3] * y[j][3]); }
#pragma unroll
        for (int j = 0; j < 8; ++j) __builtin_nontemporal_store(y[j], (f32x4*)(yr + 4 * lane + 256 * j));
        if (layer == 0) { ss = wave_sum(ss); prenorm_store(y, ss, P.in[I_GPRE] + DM, MOD + (size_t)(3 + vec) * 6144, H + (size_t)r * DM, lane); }
    }
}

DI void mla_finish(const Params& P, int layer, int gtid, int ngt) {
    unsigned char* ws = P.ws; OPAQUE_V(gtid); OPAQUE_S(ws);
    const float* CKVF = (const float*)(ws + O_CKVF); const float* CKVSS = (const float*)(ws + O_CKVSS); const float* KRF = (const float*)(ws + O_KRF); const float* ROPE = (const float*)(ws + O_ROPE);
    bf16_t* KRP = (bf16_t*)(ws + O_KRP); bf16_t* KRS = (bf16_t*)(ws + O_KRS);
#pragma unroll 4
    for (int i = gtid; i < NPR * 256; i += ngt) { const int r = i >> 8, c = i & 255; const f32x4 sa = *(const f32x4*)(CKVSS + (size_t)r * 4);
        const float rs = rsqrtf(((sa[0] + sa[1]) + (sa[2] + sa[3])) * (1.f / 256.f) + EPS);
        P.out[OUT_CKV + ((size_t)((r >> 8) * 2 + layer) * 256 + (r & 255)) * 256 + c] = CKVF[i] * rs * P.in[I_GMKV][layer * 256 + c]; }
#pragma unroll 3
    for (int i = gtid; i < NTOK * 32; i += ngt) { const int r = i >> 5, d = i & 31; const float x = KRF[i];
        if (r < NPR) { P.out[OUT_KR + ((size_t)((r >> 8) * 2 + layer) * 256 + (r & 255)) * 32 + d] = x; KRP[i] = f2bf(x); }
        else { const int rs_ = r - NPR, bs = rs_ >> 11, ts = rs_ & 2047; const int pos = (d >> 4) ? (ts & 63) : (ts >> 6); const float cs = ROPE[(pos * 8 + (d & 7)) * 2], sn = ROPE[(pos * 8 + (d & 7)) * 2 + 1];
            const float pr = KRF[i ^ 8]; const float y = x * cs + ((d & 8) ? pr : -pr) * sn;
            KRS[((size_t)(layer * 2 + bs) * 2560 + 512 + ts) * 32 + d] = f2bf(y); }
    }
}

DI int crow16(int i, int h) { return (i & 3) + 8 * (i >> 2) + 4 * h; }
DI s16x4 ld8(const LAS unsigned char* p) { return *(const LAS s16x4*)p; }
DI s16x4 ld8(const unsigned char* p) { return *(const s16x4*)p; }
template <class VP>
DI void softmax_pv(f32x16& s, float& mrun, float& lrun, f32x16& o0, f32x16& o1, VP vbase, int vstride, int r, int h) {
    float mx = s[0];
#pragma unroll
    for (int i = 1; i < 16; ++i) mx = fmaxf(mx, s[i]);
    mx = max_x32(mx);
    const float mnew = fmaxf(mrun, mx), alpha = __builtin_amdgcn_exp2f(mrun - mnew);
    float rs = 0.f;
#pragma unroll
    for (int i = 0; i < 16; ++i) { s[i] = __builtin_amdgcn_exp2f(s[i] - mnew); rs += s[i]; }
    rs = sum_x32(rs);
    lrun = lrun * alpha + rs; mrun = mnew;
    o0 *= alpha; o1 *= alpha;
#pragma unroll
    for (int s2 = 0; s2 < 2; ++s2) {
        u32x4 pw; pw.x = pk2(s[8 * s2 + 0], s[8 * s2 + 1]); pw.y = pk2(s[8 * s2 + 2], s[8 * s2 + 3]); pw.z = pk2(s[8 * s2 + 4], s[8 * s2 + 5]); pw.w = pk2(s[8 * s2 + 6], s[8 * s2 + 7]);
        const bf16x8 pb = __builtin_bit_cast(bf16x8, pw);
        {   VP p = vbase + (size_t)r * vstride + (16 * s2 + 4 * h) * 2;
            const s16x4 lo = ld8(p), hi = ld8(p + 16); const bf16x8 va = __builtin_shufflevector(lo, hi, 0, 1, 2, 3, 4, 5, 6, 7);
            o0 = MFMA32(va, pb, o0); }
        {   VP p = vbase + (size_t)(r + 32) * vstride + (16 * s2 + 4 * h) * 2;
            const s16x4 lo = ld8(p), hi = ld8(p + 16); const bf16x8 va = __builtin_shufflevector(lo, hi, 0, 1, 2, 3, 4, 5, 6, 7);
            o1 = MFMA32(va, pb, o1); }
    }
}

template <class VP>
DI void softmax_pv2(f32x16& sa, f32x16& sb, float& mrun, float& lrun, f32x16& o0, f32x16& o1, VP vbase, int vstride, int r, int h) {
    float mx = fmaxf(sa[0], sb[0]);
#pragma unroll
    for (int i = 1; i < 16; ++i) mx = fmaxf(mx, fmaxf(sa[i], sb[i]));
    mx = max_x32(mx);
    const float mnew = fmaxf(mrun, mx), alpha = __builtin_amdgcn_exp2f(mrun - mnew);
    float rs = 0.f;
#pragma unroll
    for (int i = 0; i < 16; ++i) { sa[i] = __builtin_amdgcn_exp2f(sa[i] - mnew); sb[i] = __builtin_amdgcn_exp2f(sb[i] - mnew); rs += sa[i] + sb[i]; }
    rs = sum_x32(rs);
    lrun = lrun * alpha + rs; mrun = mnew;
    o0 *= alpha; o1 *= alpha;
#pragma unroll
    for (int sub = 0; sub < 2; ++sub) {
        const f32x16& s = sub ? sb : sa;
#pragma unroll
        for (int s2 = 0; s2 < 2; ++s2) {
            u32x4 pw; pw.x = pk2(s[8 * s2 + 0], s[8 * s2 + 1]); pw.y = pk2(s[8 * s2 + 2], s[8 * s2 + 3]); pw.z = pk2(s[8 * s2 + 4], s[8 * s2 + 5]); pw.w = pk2(s[8 * s2 + 6], s[8 * s2 + 7]);
            const bf16x8 pb = __builtin_bit_cast(bf16x8, pw);
            {   VP p = vbase + (size_t)r * vstride + (32 * sub + 16 * s2 + 4 * h) * 2;
                const s16x4 lo = ld8(p), hi = ld8(p + 16); o0 = MFMA32(__builtin_shufflevector(lo, hi, 0, 1, 2, 3, 4, 5, 6, 7), pb, o0); }
            {   VP p = vbase + (size_t)(r + 32) * vstride + (32 * sub + 16 * s2 + 4 * h) * 2;
                const s16x4 lo = ld8(p), hi = ld8(p + 16); o1 = MFMA32(__builtin_shufflevector(lo, hi, 0, 1, 2, 3, 4, 5, 6, 7), pb, o1); }
        }
    }
}

DI void softmax_pv_regs(f32x16& s, float& mrun, float& lrun, f32x16& o0, f32x16& o1, const bf16x8 (&va)[2][2]) {
    float mx = s[0];
#pragma unroll
    for (int i = 1; i < 16; ++i) mx = fmaxf(mx, s[i]);
    mx = max_x32(mx);
    const float mnew = fmaxf(mrun, mx), alpha = __builtin_amdgcn_exp2f(mrun - mnew);
    float rs = 0.f;
#pragma unroll
    for (int i = 0; i < 16; ++i) { s[i] = __builtin_amdgcn_exp2f(s[i] - mnew); rs += s[i]; }
    rs = sum_x32(rs);
    lrun = lrun * alpha + rs; mrun = mnew;
    o0 *= alpha; o1 *= alpha;
#pragma unroll
    for (int s2 = 0; s2 < 2; ++s2) {
        u32x4 pw; pw.x = pk2(s[8 * s2 + 0], s[8 * s2 + 1]); pw.y = pk2(s[8 * s2 + 2], s[8 * s2 + 3]); pw.z = pk2(s[8 * s2 + 4], s[8 * s2 + 5]); pw.w = pk2(s[8 * s2 + 6], s[8 * s2 + 7]);
        const bf16x8 pb = __builtin_bit_cast(bf16x8, pw);
        o0 = MFMA32(va[s2][0], pb, o0); o1 = MFMA32(va[s2][1], pb, o1);
    }
}

struct AttnSeg { const bf16_t* K1; const bf16_t* K2; const bf16_t* VT; int vts; int nk; };

template <int NST, bool SPLIT, bool LOCAL>
DI void attn_unit(LAS unsigned char* lds, const bf16_t* Q, int qstride, const AttnSeg sa, const AttnSeg sb, const bf16_t* gate, bf16_t* outp,
                  const bf16_t* Kloc, const bf16_t* VTloc, const float* rpbh, int grow0, const int wid_in) {
    const int wid = wid_in, lane = lane_id(), tid = wid * 64 + lane, r = lane & 31, h = lane >> 5;
    const int qi = SPLIT ? (wid & 3) : wid, grp = SPLIT ? (wid >> 2) : 0;
    const int qrow = qi * 32 + r;
    bf16x8 qf[NST];
#pragma unroll
    for (int st = 0; st < NST; ++st) qf[st] = *(const bf16x8*)(Q + (size_t)qrow * qstride + 16 * st + 8 * h);
    f32x16 o0, o1;
#pragma unroll
    for (int i = 0; i < 16; ++i) { o0[i] = 0.f; o1[i] = 0.f; }
    float mrun = NEG, lrun = 0.f;
    if constexpr (LOCAL) {
        const int gr = grow0 + (qi >> 1), qc = 32 * (qi & 1) + r;
        const int kr0 = min(max(gr - 4, 0), 24), win0 = min(max(qc - 8, 0), 48);
        bf16x8 kfA[NST], kfB[NST], vaA[2][2], vaB[2][2]; float bsA[16], bsB[16];
#define LOC_LOAD(KF, VA, BS, lt) do { const int krow_ = kr0 + 4 * grp + ((lt) >> 1), c0_ = 32 * ((lt) & 1); \
            _Pragma("unroll") for (int st = 0; st < NST; ++st) KF[st] = *(const bf16x8*)(Kloc + (size_t)(krow_ * 64 + c0_ + r) * 512 + 16 * st + 8 * h); \
            _Pragma("unroll") for (int s2 = 0; s2 < 2; ++s2) _Pragma("unroll") for (int blk = 0; blk < 2; ++blk) { \
                const unsigned char* p_ = (const unsigned char*)(VTloc + krow_ * 64 + c0_) + (size_t)(r + 32 * blk) * 4096 + (16 * s2 + 4 * h) * 2; \
                const s16x4 lo_ = ld8(p_), hi_ = ld8(p_ + 16); VA[s2][blk] = __builtin_shufflevector(lo_, hi_, 0, 1, 2, 3, 4, 5, 6, 7); } \
            const float* rp_ = rpbh + (krow_ - gr + 7) * 31; \
            _Pragma("unroll") for (int i = 0; i < 16; ++i) { const int kc_ = c0_ + crow16(i, h); BS[i] = rp_[min(max(kc_ - qc + 15, 0), 30)]; } } while (0)
#define LOC_COMP(KF, VA, BS, lt) do { const int c0_ = 32 * ((lt) & 1); f32x16 s_; \
            _Pragma("unroll") for (int i = 0; i < 16; ++i) s_[i] = 0.f; \
            _Pragma("unroll") for (int st = 0; st < NST; ++st) s_ = MFMA32(KF[st], qf[st], s_); \
            _Pragma("unroll") for (int i = 0; i < 16; ++i) { const int kc_ = c0_ + crow16(i, h); const bool ok_ = (kc_ >= win0) && (kc_ < win0 + 16); s_[i] = ok_ ? s_[i] + BS[i] * LOG2E : NEG; } \
            softmax_pv_regs(s_, mrun, lrun, o0, o1, VA); } while (0)
        LOC_LOAD(kfA, vaA, bsA, 0);
#pragma unroll
        for (int lt = 0; lt < 8; lt += 2) {
            LOC_LOAD(kfB, vaB, bsB, lt + 1);
            LOC_COMP(kfA, vaA, bsA, lt);
            if (lt + 2 < 8) LOC_LOAD(kfA, vaA, bsA, lt + 2);
            LOC_COMP(kfB, vaB, bsB, lt + 1);
        }
#undef LOC_LOAD
#undef LOC_COMP
    }
    constexpr int TK = SPLIT ? 128 : 64, LTK = SPLIT ? 7 : 6;
    constexpr int VST = SPLIT ? 272 : VSTR;
    constexpr int AK1 = TK * KSTR, AV0 = 2 * TK * KSTR, AV1 = AV0 + 64 * VST, AMRG = AV0 + 2 * 64 * VST;
    static_assert(AMRG + 4 * 34 * 64 * 4 <= LDS_BAR, "attention LDS map");
    const int nta = sa.nk >> LTK, nt = nta + (sb.nk >> LTK);
    u32x4 rk1[SPLIT ? 2 : 1], rk2 = {0u, 0u, 0u, 0u}, rv[SPLIT ? 2 : 1];
#define ATT_LOAD(t) do { const bool ina = (t) < nta; const int key0 = ((t) - (ina ? 0 : nta)) * TK; \
        const bf16_t* k1_ = ina ? sa.K1 : sb.K1; const bf16_t* k2_ = ina ? sa.K2 : sb.K2; const bf16_t* vt_ = ina ? sa.VT : sb.VT; const int vts_ = ina ? sa.vts : sb.vts; \
        _Pragma("unroll") for (int q_ = 0; q_ < (SPLIT ? 2 : 1); ++q_) { \
            rk1[q_] = *(const u32x4*)(k1_ + (size_t)(key0 + 64 * q_ + (tid >> 3)) * 512 + (tid & 7) * 8); \
            rv[q_] = *(const u32x4*)(vt_ + (size_t)(tid >> 3) * vts_ + key0 + 64 * q_ + (tid & 7) * 8); } \
        if (NST == 6 && (SPLIT || tid < 256)) rk2 = *(const u32x4*)(k2_ + (size_t)(key0 + (tid >> 2)) * 32 + (tid & 3) * 8); } while (0)
#define ATT_STORE(b) do { const int kb_ = (b) ? AK1 : 0, vb_ = (b) ? AV1 : AV0; \
        _Pragma("unroll") for (int q_ = 0; q_ < (SPLIT ? 2 : 1); ++q_) { \
            *(LAS u32x4*)(lds + kb_ + (64 * q_ + (tid >> 3)) * KSTR + (tid & 7) * 16) = rk1[q_]; \
            *(LAS u32x4*)(lds + vb_ + (tid >> 3) * VST + 128 * q_ + (tid & 7) * 16) = rv[q_]; } \
        if (NST == 6 && (SPLIT || tid < 256)) *(LAS u32x4*)(lds + kb_ + (tid >> 2) * KSTR + 128 + (tid & 3) * 16) = rk2; } while (0)
    ATT_LOAD(0); ATT_STORE(0);
    __syncthreads();
#pragma unroll 1
    for (int t = 0; t < nt; ++t) {
        if (t + 1 < nt) ATT_LOAD(t + 1);
        const int kb = ((t & 1) ? AK1 : 0) + (SPLIT ? grp * 64 * KSTR : 0), vb = ((t & 1) ? AV1 : AV0) + (SPLIT ? grp * 128 : 0);
        {   f32x16 s0, s1;
#pragma unroll
            for (int i = 0; i < 16; ++i) { s0[i] = 0.f; s1[i] = 0.f; }
#pragma unroll
            for (int st = 0; st < NST; ++st) {
                const bf16x8 kf0 = *(const LAS bf16x8*)(lds + kb + r * KSTR + (16 * st + 8 * h) * 2), kf1 = *(const LAS bf16x8*)(lds + kb + (32 + r) * KSTR + (16 * st + 8 * h) * 2);
                s0 = MFMA32(kf0, qf[st], s0); s1 = MFMA32(kf1, qf[st], s1); }
            softmax_pv2(s0, s1, mrun, lrun, o0, o1, (const LAS unsigned char*)(lds + vb), VST, r, h);
        }
        if (t + 1 < nt) ATT_STORE((t + 1) & 1);
        __syncthreads();
    }
#undef ATT_LOAD
#undef ATT_STORE
    if constexpr (SPLIT) {
        LAS float* mg = (LAS float*)(lds + AMRG) + qi * 34 * 64;
        if (grp == 1) {
#pragma unroll
            for (int k = 0; k < 16; ++k) { mg[k * 64 + lane] = o0[k]; mg[(16 + k) * 64 + lane] = o1[k]; }
            mg[32 * 64 + lane] = mrun; mg[33 * 64 + lane] = lrun;
        }
        __syncthreads();
        if (grp == 0) {
            const float m2 = mg[32 * 64 + lane], l2 = mg[33 * 64 + lane], mn = fmaxf(mrun, m2), a1 = __builtin_amdgcn_exp2f(mrun - mn), a2 = __builtin_amdgcn_exp2f(m2 - mn);
            lrun = lrun * a1 + l2 * a2;
#pragma unroll
            for (int k = 0; k < 16; ++k) { o0[k] = o0[k] * a1 + mg[k * 64 + lane] * a2; o1[k] = o1[k] * a1 + mg[(16 + k) * 64 + lane] * a2; }
        }
    }
    if (!SPLIT || grp == 0) {
        const float inv = 1.f / lrun;
#pragma unroll
        for (int g4 = 0; g4 < 4; ++g4) {
            { const int dv0 = 8 * g4 + 4 * h; const u32x2 gt = *(const u32x2*)(gate + (size_t)qrow * 512 + dv0);
              u32x2 w; w.x = pk2(o0[4 * g4] * inv * bflo(gt.x), o0[4 * g4 + 1] * inv * bfhi(gt.x)); w.y = pk2(o0[4 * g4 + 2] * inv * bflo(gt.y), o0[4 * g4 + 3] * inv * bfhi(gt.y));
              *(u32x2*)(outp + (size_t)qrow * 512 + dv0) = w; }
            { const int dv0 = 32 + 8 * g4 + 4 * h; const u32x2 gt = *(const u32x2*)(gate + (size_t)qrow * 512 + dv0);
              u32x2 w; w.x = pk2(o1[4 * g4] * inv * bflo(gt.x), o1[4 * g4 + 1] * inv * bfhi(gt.x)); w.y = pk2(o1[4 * g4 + 2] * inv * bflo(gt.y), o1[4 * g4 + 3] * inv * bfhi(gt.y));
              *(u32x2*)(outp + (size_t)qrow * 512 + dv0) = w; }
        }
    }
    if constexpr (SPLIT) __syncthreads();
}

constexpr int HM_WAVE = 20480, HM_Q = 0, HM_K = 4608, HM_KT = 9216, HM_VT = 14336, HM_ER = 19456, HM_EB = 19712;
static_assert(6 * HM_WAVE <= LDS_BYTES, "hgrn LDS map");
DI bf16x8 pack8(float a0, float a1, float a2, float a3, float a4, float a5, float a6, float a7) { u32x4 w; w.x = pk2(a0, a1); w.y = pk2(a2, a3); w.z = pk2(a4, a5); w.w = pk2(a6, a7); return __builtin_bit_cast(bf16x8, w); }
DI void hgrn_pass1(unsigned char* ws, LAS unsigned char* lds, int job, int slot, int lane) {
    OPAQUE_V(lane); OPAQUE_S(ws);
    const int dir = job & 1, head = (job >> 1) & 7, gs = job >> 4;
    int tok0; if (gs < 64) tok0 = (gs >> 1) * 256 + (gs & 1) * 128; else { const int x = gs - 64; tok0 = NPR + (x >> 4) * 2048 + (x & 15) * 128; }
    const float* LF = (const float*)(ws + (dir ? O_LFB : O_LFF)); const float* HQ = (const float*)(ws + O_HQ); const float* HV = (const float*)(ws + O_HV);
    float* OP = (float*)(ws + O_OPART) + (size_t)dir * NTOK * 512; bf16_t* QE = (bf16_t*)(ws + O_QE) + (size_t)dir * NTOK * 512;
    LAS unsigned char* L = lds + slot * HM_WAVE;
    const int r31 = lane & 31, h = lane >> 5, hc = head * 64 + lane, dt = dir ? -1 : 1;
    f32x16 S[2][2];
#pragma unroll
    for (int a = 0; a < 2; ++a)
#pragma unroll
        for (int b = 0; b < 2; ++b)
#pragma unroll
            for (int i = 0; i < 16; ++i) S[a][b][i] = 0.f;
    float Bgrp = 0.f;
#pragma unroll 1
    for (int ch = 0; ch < 4; ++ch) {
        const int tbase = dir ? tok0 + 127 - 32 * ch : tok0 + 32 * ch;
        {
            {   float vv[32];
#pragma unroll
                for (int t = 0; t < 32; ++t) vv[t] = HV[(size_t)(tbase + dt * t) * 512 + hc];
#pragma unroll
                for (int q4 = 0; q4 < 4; ++q4)
                    *(LAS bf16x8*)(L + HM_VT + lane * 80 + q4 * 16) = pack8(vv[8 * q4], vv[8 * q4 + 1], vv[8 * q4 + 2], vv[8 * q4 + 3], vv[8 * q4 + 4], vv[8 * q4 + 5], vv[8 * q4 + 6], vv[8 * q4 + 7]);
            }
            asm volatile("" ::: "memory");
            float lf[32], qv[32];
#pragma unroll
            for (int t = 0; t < 32; ++t) { const size_t o = (size_t)(tbase + dt * t) * 512 + hc; lf[t] = LF[o]; qv[t] = HQ[o]; }
#pragma unroll
            for (int t = 1; t < 32; ++t) lf[t] += lf[t - 1];
            const float bend = lf[31], r = 0.5f * bend, eg = __expf(Bgrp + r);
            float ekp = __expf(r);
#pragma unroll
            for (int q4 = 0; q4 < 4; ++q4) {
                float kt[8];
#pragma unroll
                for (int u = 0; u < 8; ++u) { const int t = 8 * q4 + u;
                    const float eq = __expf(lf[t] - r), ek = __expf(r - lf[t]);
                    const float f = eq * ekp; ekp = ek;
                    const float qt = qv[t] * eq; kt[u] = (1.f - f) * ek;
                    QE[(size_t)(tbase + dt * t) * 512 + hc] = f2bf(qt * eg);
                    *(LAS bf16_t*)(L + HM_Q + t * 144 + lane * 2) = f2bf(qt);
                    *(LAS bf16_t*)(L + HM_K + t * 144 + lane * 2) = f2bf(kt[u]); }
                *(LAS bf16x8*)(L + HM_KT + lane * 80 + q4 * 16) = pack8(kt[0], kt[1], kt[2], kt[3], kt[4], kt[5], kt[6], kt[7]);
            }
            *(LAS float*)(L + HM_ER + lane * 4) = __expf(r); *(LAS float*)(L + HM_EB + lane * 4) = __expf(bend);
            Bgrp += bend;
        }
        LDSW();
        f32x16 X;
#pragma unroll
        for (int i = 0; i < 16; ++i) X[i] = 0.f;
#pragma unroll
        for (int st = 0; st < 4; ++st) { const bf16x8 a = *(const LAS bf16x8*)(L + HM_K + r31 * 144 + (16 * st + 8 * h) * 2), bq = *(const LAS bf16x8*)(L + HM_Q + r31 * 144 + (16 * st + 8 * h) * 2); X = MFMA32(a, bq, X); }
#pragma unroll
        for (int i = 0; i < 16; ++i) X[i] = (crow16(i, h) > r31) ? 0.f : X[i];
        f32x16 O0, O1;
#pragma unroll
        for (int i = 0; i < 16; ++i) { O0[i] = 0.f; O1[i] = 0.f; }
#pragma unroll
        for (int s2 = 0; s2 < 2; ++s2) {
            const bf16x8 pb = pack8(X[8 * s2], X[8 * s2 + 1], X[8 * s2 + 2], X[8 * s2 + 3], X[8 * s2 + 4], X[8 * s2 + 5], X[8 * s2 + 6], X[8 * s2 + 7]);
            { const LAS unsigned char* p = L + HM_VT + r31 * 80 + (16 * s2 + 4 * h) * 2; const s16x4 lo = ld8(p), hi = ld8(p + 16); O0 = MFMA32(__builtin_shufflevector(lo, hi, 0, 1, 2, 3, 4, 5, 6, 7), pb, O0); }
            { const LAS unsigned char* p = L + HM_VT + (32 + r31) * 80 + (16 * s2 + 4 * h) * 2; const s16x4 lo = ld8(p), hi = ld8(p + 16); O1 = MFMA32(__builtin_shufflevector(lo, hi, 0, 1, 2, 3, 4, 5, 6, 7), pb, O1); }
        }
#pragma unroll
        for (int kb = 0; kb < 2; ++kb)
#pragma unroll
            for (int s2 = 0; s2 < 2; ++s2) {
                const LAS unsigned char* qp = L + HM_Q + r31 * 144 + (32 * kb + 16 * s2 + 4 * h) * 2; const s16x4 lo = ld8(qp), hi = ld8(qp + 16);
                const bf16x8 bqp = __builtin_shufflevector(lo, hi, 0, 1, 2, 3, 4, 5, 6, 7);
                const f32x4 e0 = *(const LAS f32x4*)(L + HM_ER + (32 * kb + 16 * s2 + 4 * h) * 4), e1 = *(const LAS f32x4*)(L + HM_ER + (32 * kb + 16 * s2 + 8 + 4 * h) * 4);
                { const f32x16& Sb = S[kb][0]; const bf16x8 a = pack8(Sb[8 * s2] * e0[0], Sb[8 * s2 + 1] * e0[1], Sb[8 * s2 + 2] * e0[2], Sb[8 * s2 + 3] * e0[3], Sb[8 * s2 + 4] * e1[0], Sb[8 * s2 + 5] * e1[1], Sb[8 * s2 + 6] * e1[2], Sb[8 * s2 + 7] * e1[3]);
                  O0 = MFMA32(a, bqp, O0); }
                { const f32x16& Sb = S[kb][1]; const bf16x8 a = pack8(Sb[8 * s2] * e0[0], Sb[8 * s2 + 1] * e0[1], Sb[8 * s2 + 2] * e0[2], Sb[8 * s2 + 3] * e0[3], Sb[8 * s2 + 4] * e1[0], Sb[8 * s2 + 5] * e1[1], Sb[8 * s2 + 6] * e1[2], Sb[8 * s2 + 7] * e1[3]);
                  O1 = MFMA32(a, bqp, O1); }
            }
        {   float* op = OP + (size_t)(tbase + dt * r31) * 512 + head * 64 + 4 * h;
#pragma unroll
            for (int g4 = 0; g4 < 4; ++g4) { *(f32x4*)(op + 8 * g4) = (f32x4){O0[4 * g4], O0[4 * g4 + 1], O0[4 * g4 + 2], O0[4 * g4 + 3]}; *(f32x4*)(op + 32 + 8 * g4) = (f32x4){O1[4 * g4], O1[4 * g4 + 1], O1[4 * g4 + 2], O1[4 * g4 + 3]}; }
        }
#pragma unroll
        for (int kb = 0; kb < 2; ++kb) {
            f32x4 er[4], eb[4];
#pragma unroll
            for (int g4 = 0; g4 < 4; ++g4) { er[g4] = *(const LAS f32x4*)(L + HM_ER + (32 * kb + 8 * g4 + 4 * h) * 4); eb[g4] = *(const LAS f32x4*)(L + HM_EB + (32 * kb + 8 * g4 + 4 * h) * 4); }
#pragma unroll
            for (int vb = 0; vb < 2; ++vb) {
                f32x16 T;
#pragma unroll
                for (int i = 0; i < 16; ++i) T[i] = 0.f;
#pragma unroll
                for (int st = 0; st < 2; ++st) { const bf16x8 a = *(const LAS bf16x8*)(L + HM_KT + (32 * kb + r31) * 80 + (16 * st + 8 * h) * 2), bv = *(const LAS bf16x8*)(L + HM_VT + (32 * vb + r31) * 80 + (16 * st + 8 * h) * 2); T = MFMA32(a, bv, T); }
#pragma unroll
                for (int i = 0; i < 16; ++i) S[kb][vb][i] = eb[i >> 2][i & 3] * S[kb][vb][i] + er[i >> 2][i & 3] * T[i];
            }
        }
        LDSW();
    }
    float* SG = (float*)(ws + O_SGRP) + (size_t)job * 4096;
#pragma unroll
    for (int kb = 0; kb < 2; ++kb)
#pragma unroll
        for (int vb = 0; vb < 2; ++vb)
#pragma unroll
            for (int i = 0; i < 16; ++i) SG[((kb * 2 + vb) * 16 + i) * 64 + lane] = S[kb][vb][i];
    ((float*)(ws + O_DGRP))[job * 64 + lane] = Bgrp;
}
DI void hgrn_pass2(const Params& P, int layer, int job, int lane) {
    unsigned char* ws = P.ws; OPAQUE_V(lane); OPAQUE_S(ws);
    const int c = job & 3, head = (job >> 2) & 7, gs = job >> 5;
    int b, g, ng, gsbase, tokg0; bool prompt;
    if (gs < 64) { prompt = true; b = gs >> 1; g = gs & 1; ng = 2; gsbase = gs & ~1; tokg0 = b * 256 + g * 128; }
    else { const int x = gs - 64; prompt = false; b = x >> 4; g = x & 15; ng = 16; gsbase = 64 + (x & ~15); tokg0 = NPR + b * 2048 + g * 128; }
    const int r31 = lane & 31, h = lane >> 5, t = tokg0 + 32 * c + r31;
    const float* SGRP = (const float*)(ws + O_SGRP);
    f32x16 O0, O1;
#pragma unroll
    for (int i = 0; i < 16; ++i) { O0[i] = 0.f; O1[i] = 0.f; }
#pragma unroll 1
    for (int dir = 0; dir < 2; ++dir) {
        const int gp = dir ? ng - 1 - g : g;
        if (prompt && gp == 0) continue;
        const int jq = ((gsbase + g) * 8 + head) * 2 + dir;
        const float* src = prompt ? SGRP + (size_t)(((gsbase + (g ^ 1)) * 8 + head) * 2 + dir) * 4096 : (const float*)(ws + O_GST) + (size_t)(jq - 1024) * 4096;
        f32x16 Gs[2][2];
#pragma unroll
        for (int kb = 0; kb < 2; ++kb)
#pragma unroll
            for (int vb = 0; vb < 2; ++vb)
#pragma unroll
                for (int i = 0; i < 16; ++i) Gs[kb][vb][i] = src[((kb * 2 + vb) * 16 + i) * 64 + lane];
        const bf16_t* qe = (const bf16_t*)(ws + O_QE) + (size_t)dir * NTOK * 512 + (size_t)t * 512 + head * 64;
#pragma unroll
        for (int kb = 0; kb < 2; ++kb)
#pragma unroll
            for (int s2 = 0; s2 < 2; ++s2) {
                const s16x4 lo = *(const s16x4*)(qe + 32 * kb + 16 * s2 + 4 * h), hi = *(const s16x4*)(qe + 32 * kb + 16 * s2 + 8 + 4 * h);
                const bf16x8 bqp = __builtin_shufflevector(lo, hi, 0, 1, 2, 3, 4, 5, 6, 7);
                { const f32x16& Sb = Gs[kb][0]; O0 = MFMA32(pack8(Sb[8 * s2], Sb[8 * s2 + 1], Sb[8 * s2 + 2], Sb[8 * s2 + 3], Sb[8 * s2 + 4], Sb[8 * s2 + 5], Sb[8 * s2 + 6], Sb[8 * s2 + 7]), bqp, O0); }
                { const f32x16& Sb = Gs[kb][1]; O1 = MFMA32(pack8(Sb[8 * s2], Sb[8 * s2 + 1], Sb[8 * s2 + 2], Sb[8 * s2 + 3], Sb[8 * s2 + 4], Sb[8 * s2 + 5], Sb[8 * s2 + 6], Sb[8 * s2 + 7]), bqp, O1); }
            }
    }
    const size_t ob = (size_t)t * 512 + head * 64 + 4 * h;
    const float* OP0 = (const float*)(ws + O_OPART) + ob; const float* OP1 = OP0 + (size_t)NTOK * 512;
    f32x4 tot[8]; float ss = 0.f;
#pragma unroll
    for (int g4 = 0; g4 < 4; ++g4) {
        tot[g4] = (f32x4){O0[4 * g4], O0[4 * g4 + 1], O0[4 * g4 + 2], O0[4 * g4 + 3]} + *(const f32x4*)(OP0 + 8 * g4) + *(const f32x4*)(OP1 + 8 * g4);
        tot[4 + g4] = (f32x4){O1[4 * g4], O1[4 * g4 + 1], O1[4 * g4 + 2], O1[4 * g4 + 3]} + *(const f32x4*)(OP0 + 32 + 8 * g4) + *(const f32x4*)(OP1 + 32 + 8 * g4);
    }
#pragma unroll
    for (int q = 0; q < 8; ++q) ss += (tot[q][0] * tot[q][0] + tot[q][1] * tot[q][1]) + (tot[q][2] * tot[q][2] + tot[q][3] * tot[q][3]);
    ss = sum_x32(ss);
    const float rstd = rsqrtf(ss * (1.f / 64.f) + EPS);
    const float* gh = P.in[I_GHG] + layer * 512 + head * 64 + 4 * h; const bf16_t* GHG = (const bf16_t*)(ws + O_GHG) + ob; bf16_t* OHG = (bf16_t*)(ws + O_OBR) + (size_t)2 * NTOK * 512 + ob;
#pragma unroll
    for (int q = 0; q < 8; ++q) { const int vo = (q >> 2) * 32 + 8 * (q & 3);
        const f32x4 gg = *(const f32x4*)(gh + vo); const u32x2 gt = *(const u32x2*)(GHG + vo);
        u32x2 w; w.x = pk2(tot[q][0] * rstd * gg[0] * bflo(gt.x), tot[q][1] * rstd * gg[1] * bfhi(gt.x)); w.y = pk2(tot[q][2] * rstd * gg[2] * bflo(gt.y), tot[q][3] * rstd * gg[3] * bfhi(gt.y));
        *(u32x2*)(OHG + vo) = w; }
}

DI void hgrn_scan(const Params& P, int layer, int gtid, int ngt) {
    unsigned char* ws = P.ws; OPAQUE_V(gtid); OPAQUE_S(ws);
    const float* SGRP = (const float*)(ws + O_SGRP); const float* DGRP = (const float*)(ws + O_DGRP); float* GST = (float*)(ws + O_GST);
#pragma unroll 4
    for (int e = gtid; e < 32 * 8 * 2 * 4096; e += ngt) {
        const int kv = e & 4095, dir = (e >> 12) & 1, head = (e >> 13) & 7, b = e >> 16, k = kv >> 6, v = kv & 63;
        const int kk = k & 31, hh = (kk >> 2) & 1, ii = (kk & 3) + 4 * (kk >> 3), el = ((((k >> 5) * 2 + (v >> 5)) * 16 + ii) * 64) + hh * 32 + (v & 31);
        const int jf = ((2 * b + (dir ? 1 : 0)) * 8 + head) * 2 + dir, jl = ((2 * b + (dir ? 0 : 1)) * 8 + head) * 2 + dir;
        P.out[(dir ? OUT_SB : OUT_SF) + ((size_t)(b * 2 + layer) * 8 + head) * 4096 + kv] = __expf(DGRP[jl * 64 + k]) * SGRP[(size_t)jf * 4096 + el] + SGRP[(size_t)jl * 4096 + el];
    }
    for (int e = gtid; e < 32 * 4096; e += ngt) {
        const int seq = e >> 12, el = e & 4095, ri = el >> 6, ln = el & 63, blk = ri >> 4, i = ri & 15;
        const int k = 32 * (blk >> 1) + crow16(i, ln >> 5), v = 32 * (blk & 1) + (ln & 31), b = seq >> 4, head = (seq >> 1) & 7, dir = seq & 1;
        float Gv = P.in[dir ? I_SB : I_SF][((size_t)(b * 2 + layer) * 8 + head) * 4096 + k * 64 + v];
        float dv[16], sv[16];
#pragma unroll
        for (int p = 0; p < 16; ++p) { const int gq = dir ? 15 - p : p, jq = ((64 + b * 16 + gq) * 8 + head) * 2 + dir; dv[p] = DGRP[jq * 64 + k]; sv[p] = SGRP[(size_t)jq * 4096 + el]; }
#pragma unroll
        for (int p = 0; p < 16; ++p) { const int gq = dir ? 15 - p : p, jq = ((64 + b * 16 + gq) * 8 + head) * 2 + dir; GST[(size_t)(jq - 1024) * 4096 + el] = Gv; Gv = __expf(dv[p]) * Gv + sv[p]; }
    }
}

__global__ void __launch_bounds__(512, 2) fwd_kernel(Params P) {
    extern __shared__ __attribute__((aligned(16))) unsigned char lds_raw[];
    LAS unsigned char* lds = (LAS unsigned char*)lds_raw;
    cg::grid_group grid = cg::this_grid();
    const int tid = threadIdx.x, wid = __builtin_amdgcn_readfirstlane(tid >> 6), lane = tid & 63, bid = blockIdx.x; constexpr int G = 256;
    const int gw = bid * 8 + wid, ngw = G * 8, gtid = bid * 512 + tid, ngt = G * 512;
    unsigned char* ws = P.ws;
    if (tid < 16) ((LAS unsigned*)(lds + LDS_BAR))[tid] = 0u;
    __syncthreads();
    (void)xcd_barrier_post((unsigned*)(ws + O_CTL), (volatile LAS unsigned*)(lds + LDS_BAR));
#define GRID_BAR() do { XcdBarrier b_; unsigned char* wb_ = P.ws; OPAQUE_S(wb_); b_.bar = (unsigned*)(wb_ + O_CTL); b_.x = xb_xcc_id(); b_.st = (volatile LAS unsigned*)(lds + LDS_BAR); xcd_barrier(b_); } while (0)

    for (int rep_ = 0; rep_ < REP_S0; ++rep_) {
#ifndef SKIP_S0
    for (int j = bid; j < 192; j += G) setup_gemv(P, lds, j, tid, wid, lane);
    setup_convert(P, gtid, ngt);
    setup_transposes(P, lds, gw, ngw, wid, lane);
#endif

    }
    grid.sync();

#ifndef SKIP_S1
#pragma unroll 1
    for (int l = 0; l < 2; ++l) {
        pg8::Gemm g{(const bf16_t*)(ws + O_CCKV) + (size_t)l * 1024 * 256, (const bf16_t*)(ws + O_WUKV) + (size_t)l * 1024 * 256, 1024, 1024, 256, 0, 0};
        pg8::StaticOrder S; S.init(1024, 1024, G, (bid + G - 16 * l) % G, 1);
        EpiKV E{ws, l, 1};
        pg8::gemm_phase<EpiKV, pg8::StaticOrder>(lds, g, S, E, wid);
    }
    prenorm_layer0(P, gw, ngw, lane);
#endif

    GRID_BAR();

#pragma unroll 1
    for (int l = 0; l < 2; ++l) {
        unsigned char* ws = P.ws; OPAQUE_S(ws);
#pragma unroll 1
        for (int rep_ = 0; rep_ < REP_L1; ++rep_) {
#ifndef SKIP_L1
        {   pg8::Gemm g{(const bf16_t*)(ws + O_H), (const bf16_t*)(ws + O_WIN) + (size_t)l * NPROJ * DM, NTOK, NPROJ, DM, 0, 0};
            pg8::StaticOrder S; S.init(NTOK, NPROJ, G, opq_s(bid), 1);
            EpiIn E{ws, P.out, l, P.in[I_LBF], P.in[I_LBB]};
            pg8::gemm_phase<EpiIn, pg8::StaticOrder>(lds, g, S, E, wid); }
#endif

        }
        GRID_BAR();

        ws = P.ws; OPAQUE_S(ws);
#pragma unroll 1
        for (int rep_ = 0; rep_ < REP_L2; ++rep_) {
#ifndef SKIP_UQ
        ws = P.ws; OPAQUE_S(ws);
        {   pg8::Gemm g{(const bf16_t*)(ws + O_CQ), (const bf16_t*)(ws + O_WUQ) + (size_t)l * 768 * 512, NTOK, 768, 512, 0, 0};
            pg8::StaticOrder S; S.init(NTOK, 768, G, opq_s(bid), 1);
            EpiUQ E{ws};
            pg8::gemm_phase<EpiUQ, pg8::StaticOrder>(lds, g, S, E, wid); }
#endif

#ifndef SKIP_KV
        ws = P.ws; OPAQUE_S(ws);
        {   pg8::Gemm g{(const bf16_t*)(ws + O_CKVB), (const bf16_t*)(ws + O_WUKVG) + (size_t)l * 1024 * 256, NTOK, 1024, 256, 0, 0};
            pg8::StaticOrder S; { const int b2 = opq_s(bid); S.init(NTOK, 1024, 112, b2 >= 144 ? b2 - 144 : 100000, 1); }
            EpiKV E{ws, l, 0};
            pg8::gemm_phase<EpiKV, pg8::StaticOrder>(lds, g, S, E, wid); }
        mla_finish(P, l, bid * 512 + wid * 64 + lane_id(), ngt);
#endif

#pragma unroll 1
        for (int rq_ = 0; rq_ < REP_NAP; ++rq_) {
#ifndef SKIP_NAP
        ws = P.ws; OPAQUE_S(ws);
        for (int u = opq_s(bid); u < 256; u += G) {
            const int b = u >> 3, head = u & 7; const size_t r0 = (size_t)b * 256;
            const AttnSeg sa{nullptr, nullptr, nullptr, 0, 0};
            const AttnSeg sb{(const bf16_t*)(ws + O_KA) + r0 * 512 + head * 64, nullptr, (const bf16_t*)(ws + O_VTA) + (size_t)(b * 8 + head) * 64 * 256, 256, 256};
            attn_unit<4, false, false>(lds, (const bf16_t*)(ws + O_QA) + r0 * 512 + head * 64, 512, sa, sb, (const bf16_t*)(ws + O_GNA) + r0 * 512 + head * 64,
                                       (bf16_t*)(ws + O_OBR) + r0 * 512 + head * 64, nullptr, nullptr, nullptr, 0, wid);
        }
#endif
        }


#pragma unroll 1
        for (int rq_ = 0; rq_ < REP_NAS; ++rq_) {
#ifndef SKIP_NAS
        ws = P.ws; OPAQUE_S(ws);
        for (int u = opq_s(bid); u < 256; u += G) {
            const int pair_ = (u & 7) * 2 + (u >> 7), bs = pair_ >> 3, head = pair_ & 7, grow0 = 2 * ((u >> 3) & 15);     const size_t rb = (size_t)NPR + (size_t)bs * 2048, r0 = rb + (size_t)grow0 * 64;
            const AttnSeg sa{(const bf16_t*)(ws + O_CKA) + (size_t)(l * 2 + bs) * 512 * 512 + head * 64, nullptr, (const bf16_t*)(ws + O_CVTA) + (size_t)((l * 2 + bs) * 8 + head) * 64 * 512, 512, 512};
            const AttnSeg sb{nullptr, nullptr, nullptr, 0, 0};
            attn_unit<4, true, true>(lds, (const bf16_t*)(ws + O_QA) + r0 * 512 + head * 64, 512, sa, sb, (const bf16_t*)(ws + O_GNA) + r0 * 512 + head * 64,
                                     (bf16_t*)(ws + O_OBR) + r0 * 512 + head * 64, (const bf16_t*)(ws + O_KA) + rb * 512 + head * 64,
                                     (const bf16_t*)(ws + O_VTA) + (size_t)4194304 + (size_t)(bs * 8 + head) * 64 * 2048, P.in[I_RPB] + (size_t)(l * 8 + head) * 15 * 31, grow0, wid);
        }
#endif
        }


#pragma unroll 1
        for (int rq_ = 0; rq_ < REP_H1; ++rq_) {
#ifndef SKIP_H1
        ws = P.ws; OPAQUE_S(ws);
        if (wid < 6) for (int j = wid * G + opq_s(bid); j < 1536; j += 6 * G) hgrn_pass1(ws, lds, j, wid, lane_id());
#endif
        }


        }
        GRID_BAR();

        ws = P.ws; OPAQUE_S(ws);
        hgrn_scan(P, l, bid * 512 + wid * 64 + lane_id(), ngt);
#pragma unroll 1
        for (int rep_ = 0; rep_ < REP_L3; ++rep_) {
#pragma unroll 1
        for (int rq_ = 0; rq_ < REP_MLAP; ++rq_) {
#ifndef SKIP_MLAP
        ws = P.ws; OPAQUE_S(ws);
        for (int u = opq_s(bid); u < 256; u += G) {
            const int b = u >> 3, head = u & 7; const size_t r0 = (size_t)b * 256;
            const AttnSeg sa{nullptr, nullptr, nullptr, 0, 0};
            const AttnSeg sb{(const bf16_t*)(ws + O_KNP) + r0 * 512 + head * 64, (const bf16_t*)(ws + O_KRP) + r0 * 32, (const bf16_t*)(ws + O_VTMP) + (size_t)(b * 8 + head) * 64 * 256, 256, 256};
            attn_unit<6, false, false>(lds, (const bf16_t*)(ws + O_QM) + r0 * 768 + head * 96, 768, sa, sb, (const bf16_t*)(ws + O_GMLA) + r0 * 512 + head * 64,
                                       (bf16_t*)(ws + O_OBR) + (size_t)NTOK * 512 + r0 * 512 + head * 64, nullptr, nullptr, nullptr, 0, wid);
        }
#endif
        }


#pragma unroll 1
        for (int rq_ = 0; rq_ < REP_MLAS; ++rq_) {
#ifndef SKIP_MLAS
        ws = P.ws; OPAQUE_S(ws);
        for (int u = opq_s(bid); u < 256; u += G) {
            const int pair_ = (u & 7) * 2 + (u >> 7), bs = pair_ >> 3, head = pair_ & 7, qb = (u >> 3) & 15;     const size_t r0 = (size_t)NPR + (size_t)bs * 2048 + (size_t)qb * 128;
            const AttnSeg sa{(const bf16_t*)(ws + O_KNS) + (size_t)(l * 2 + bs) * 2560 * 512 + head * 64, (const bf16_t*)(ws + O_KRS) + (size_t)(l * 2 + bs) * 2560 * 32,
                             (const bf16_t*)(ws + O_VTMS) + (size_t)((l * 2 + bs) * 8 + head) * 64 * 2560, 2560, 2560};
            const AttnSeg sb{nullptr, nullptr, nullptr, 0, 0};
            attn_unit<6, true, false>(lds, (const bf16_t*)(ws + O_QM) + r0 * 768 + head * 96, 768, sa, sb, (const bf16_t*)(ws + O_GMLA) + r0 * 512 + head * 64,
                                      (bf16_t*)(ws + O_OBR) + (size_t)NTOK * 512 + r0 * 512 + head * 64, nullptr, nullptr, nullptr, 0, wid);
        }
#endif
        }


        GRID_BAR();
#pragma unroll 1
        for (int rq_ = 0; rq_ < REP_H2; ++rq_) {
#ifndef SKIP_H2
        ws = P.ws; OPAQUE_S(ws);
        for (int j = wid * G + opq_s(bid); j < 3072; j += 8 * G) hgrn_pass2(P, l, j, lane_id());
#endif
        }


        }
        GRID_BAR();

        ws = P.ws; OPAQUE_S(ws);
        {   unsigned* cntl = (unsigned*)(ws + O_CNT) + (size_t)l * 48 * 64;
#pragma unroll 1
            for (int pass = 0; pass < 2; ++pass) {
                const int b2 = opq_s(bid);
                pg8::Gemm g{(const bf16_t*)(ws + O_OBR) + (pass ? (size_t)NPR * 512 : 0), (const bf16_t*)(ws + O_WBR) + (size_t)l * 3 * DM * 512, pass ? NSM : NPR, DM, 512, (size_t)NTOK * 512 * 2, (size_t)DM * 512 * 2};
                pg8::StaticOrder S; S.init(pass ? NSM : NPR, DM, pass ? 128 : G, pass ? (b2 < 128 ? b2 : 100000) : b2, 3);
                EpiMerge E{ws, pass ? 32 : 0, cntl};
                pg8::gemm_phase<EpiMerge, pg8::StaticOrder>(lds, g, S, E, wid);
            }
            {   const int b2 = opq_s(bid); const bool lat = b2 < 128;
                pg8::Gemm g{(const bf16_t*)(ws + O_MERGED) + (lat ? (size_t)NPR * DM : 0), (const bf16_t*)(ws + O_WOUT) + (size_t)l * DM * DM, lat ? NSM : NPR, DM, DM, 0, 0};
                pg8::CountedOrder S; S.init(lat ? NSM : NPR, DM, 128, lat ? b2 : b2 - 128, 1); S.ready = cntl; S.need = 64u; S.pm0 = lat ? 32 : 0; S.wid = wid;
                EpiOut E{ws, lat ? 32 : 0};
                pg8::gemm_phase<EpiOut, pg8::CountedOrder>(lds, g, S, E, wid);
            }
        }
        GRID_BAR();

#ifndef SKIP_L6
        postnorm_phase(P, l, bid * 8 + wid, ngw, lane_id());
#endif

        if (l == 0) GRID_BAR();
    }
}

extern "C" void kernel_launch(void* const* d_in, const int* in_sizes, int n_in, void* d_out, int out_size, void* d_ws, size_t ws_size, hipStream_t stream) {
    static int grid = 0;
    if (grid == 0) {
        if (n_in != 27 || (size_t)out_size != OUT_END || ws_size < WS_TOTAL) { fprintf(stderr, "kernel_launch: unexpected shapes: n_in %d out %d ws %zu (need %zu)\n", n_in, out_size, ws_size, (size_t)WS_TOTAL); grid = -1; return; }
        int dev = 0, cus = 0, per_cu = 0;
        if (hipGetDevice(&dev) != hipSuccess || hipDeviceGetAttribute(&cus, hipDeviceAttributeMultiprocessorCount, dev) != hipSuccess) { fprintf(stderr, "kernel_launch: device query failed\n"); grid = -1; return; }
        if (hipFuncSetAttribute((const void*)fwd_kernel, hipFuncAttributeMaxDynamicSharedMemorySize, LDS_BYTES) != hipSuccess) { fprintf(stderr, "kernel_launch: hipFuncSetAttribute failed\n"); grid = -1; return; }
        if (hipOccupancyMaxActiveBlocksPerMultiprocessor(&per_cu, (const void*)fwd_kernel, 512, LDS_BYTES) != hipSuccess || per_cu < 1) { fprintf(stderr, "kernel_launch: occupancy query says %d blocks per CU\n", per_cu); (void)hipGetLastError(); per_cu = 1; }
        grid = cus * 1;
        if (grid != 256) { fprintf(stderr, "kernel_launch: needs more than 128 CUs (got %d): layer 1's weight copy is made by workgroups 128.. of the grid\n", cus); grid = -1; return; }
    }
    if (grid < 0) return;
    if (hipMemsetAsync((unsigned char*)d_ws + O_CTL, 0, CTL_BYTES, stream) != hipSuccess) { fprintf(stderr, "kernel_launch: memset of the barrier words failed\n"); return; }
    Params p{};
    for (int i = 0; i < 27; ++i) p.in[i] = (const float*)d_in[i];
    p.out = (float*)d_out; p.ws = (unsigned char*)d_ws;
    void* args[] = {&p};
    hipError_t e = hipLaunchCooperativeKernel((const void*)fwd_kernel, dim3(grid), dim3(512), args, LDS_BYTES, stream);
    if (e != hipSuccess) fprintf(stderr, "kernel_launch: cooperative launch failed: %s (grid %d)\n", hipGetErrorString(e), grid);
}
```

```cpp
#include <hip/hip_runtime.h>
#include <hip/hip_cooperative_groups.h>
#include <cstdio>
#include <cstdint>
namespace cg = cooperative_groups;
#ifndef REP_L1
#define REP_L1 1
#endif
#ifndef REP_L2
#define REP_L2 1
#endif
#ifndef REP_L3
#define REP_L3 1
#endif
#ifndef REP_L4
#define REP_L4 1
#endif
#ifndef REP_L5
#define REP_L5 1
#endif
#ifndef REP_NAP
#define REP_NAP 1
#endif
#ifndef REP_NAS
#define REP_NAS 1
#endif
#ifndef REP_H1
#define REP_H1 1
#endif
#ifndef REP_MLAP
#define REP_MLAP 1
#endif
#ifndef REP_MLAS
#define REP_MLAS 1
#endif
#ifndef REP_H2
#define REP_H2 1
#endif
#ifndef REP_S0
#define REP_S0 1
#endif

#define DI __device__ __forceinline__
#define OPAQUE_V(x) asm volatile("" : "+v"(x))
#define OPAQUE_S(x) asm volatile("" : "+s"(x))
__device__ __forceinline__ int opq_s(int x) { asm volatile("" : "+s"(x)); return x; }
__device__ __forceinline__ int lane_id() { int l; asm volatile("v_mbcnt_lo_u32_b32 %0, -1, 0\n\tv_mbcnt_hi_u32_b32 %0, -1, %0" : "=v"(l)); return l; }
#define LAS __attribute__((address_space(3)))
typedef unsigned short bf16_t;
typedef short bf16x8 __attribute__((ext_vector_type(8)));
typedef short s16x4 __attribute__((ext_vector_type(4)));
typedef float f32x4 __attribute__((ext_vector_type(4)));
typedef float f32x2 __attribute__((ext_vector_type(2)));
typedef float f32x16 __attribute__((ext_vector_type(16)));
typedef unsigned u32x4 __attribute__((ext_vector_type(4)));
typedef unsigned u32x2 __attribute__((ext_vector_type(2)));
typedef __bf16 bf16v2 __attribute__((ext_vector_type(2)));

DI unsigned pk2(float a, float b) { bf16v2 v = __builtin_convertvector((f32x2){a, b}, bf16v2); return __builtin_bit_cast(unsigned, v); }
DI bf16_t f2bf(float a) { return (bf16_t)(pk2(a, 0.f) & 0xffffu); }
DI float bf2f(unsigned u16) { return __uint_as_float(u16 << 16); }
DI float bflo(unsigned w) { return __uint_as_float(w << 16); }
DI float bfhi(unsigned w) { return __uint_as_float(w & 0xffff0000u); }
DI float sigmoidf_(float x) { return __builtin_amdgcn_rcpf(1.f + __expf(-x)); }
DI float siluf_(float x) { return x * sigmoidf_(x); }
template <int XM> DI float xor_swz(float x) { return __int_as_float(__builtin_amdgcn_ds_swizzle(__float_as_int(x), (XM << 10) | 0x1f)); }
DI float max_x32(float x) { const auto r = __builtin_amdgcn_permlane32_swap(__float_as_uint(x), __float_as_uint(x), false, false); return fmaxf(__uint_as_float(r[0]), __uint_as_float(r[1])); }
DI float sum_x32(float x) { const auto r = __builtin_amdgcn_permlane32_swap(__float_as_uint(x), __float_as_uint(x), false, false); return __uint_as_float(r[0]) + __uint_as_float(r[1]); }
DI float wave_sum(float v) {
    v += xor_swz<1>(v); v += xor_swz<2>(v); v += xor_swz<4>(v); v += xor_swz<8>(v); v += xor_swz<16>(v); v = sum_x32(v);
    return v;
}

constexpr int DM = 2048, NTOK = 12288, NPR = 8192, NSM = 4096, PSEQ = 256, SSEQ = 2048, PAST = 512, NPROJ = 12288, PROJ_ORIG = 12064;
constexpr float EPS = 1e-6f, LOG2E = 1.4426950408889634f;
constexpr float QS_NA = 0.125f * LOG2E;
constexpr float QS_MLA = 0.10206207261596575f * LOG2E;
constexpr float NEG = -1e30f;

constexpr size_t al256(size_t x) { return (x + 255) & ~(size_t)255; }
constexpr size_t O_WIN = 0;
constexpr size_t O_WOUT = O_WIN + al256((size_t)2 * NPROJ * DM * 2);
constexpr size_t O_WBR = O_WOUT + al256((size_t)2 * DM * DM * 2);
constexpr size_t O_WUQ = O_WBR + al256((size_t)2 * 3 * DM * 512 * 2);
constexpr size_t O_WUKV = O_WUQ + al256((size_t)2 * 768 * 512 * 2);
constexpr size_t O_WUKVG = O_WUKV + al256((size_t)2 * 1024 * 256 * 2);
constexpr size_t O_MOD = O_WUKVG + al256((size_t)2 * 1024 * 256 * 2);
constexpr size_t O_ROPE = O_MOD + al256((size_t)2 * 3 * 6144 * 4);
constexpr size_t O_CKA = O_ROPE + al256((size_t)64 * 8 * 2 * 4);
constexpr size_t O_CVTA = O_CKA + al256((size_t)2 * 2 * 512 * 512 * 2);
constexpr size_t O_CCKV = O_CVTA + al256((size_t)2 * 2 * 512 * 512 * 2);
constexpr size_t O_KNS = O_CCKV + al256((size_t)2 * 2 * 512 * 256 * 2);
constexpr size_t O_KRS = O_KNS + al256((size_t)2 * 2 * 2560 * 512 * 2);
constexpr size_t O_VTMS = O_KRS + al256((size_t)2 * 2 * 2560 * 32 * 2);
constexpr size_t O_H = O_VTMS + al256((size_t)2 * 2 * 8 * 64 * 2560 * 2);
constexpr size_t O_QA = O_H + al256((size_t)NTOK * DM * 2);
constexpr size_t O_KA = O_QA + al256((size_t)NTOK * 512 * 2);
constexpr size_t O_VTA = O_KA + al256((size_t)NTOK * 512 * 2);
constexpr size_t O_GNA = O_VTA + al256((size_t)NTOK * 512 * 2);
constexpr size_t O_CQ = O_GNA + al256((size_t)NTOK * 512 * 2);
constexpr size_t O_CQSS = O_CQ + al256((size_t)NTOK * 512 * 2);
constexpr size_t O_CKVB = O_CQSS + al256((size_t)NTOK * 8 * 4);
constexpr size_t O_CKVF = O_CKVB + al256((size_t)NTOK * 256 * 2);
constexpr size_t O_CKVSS = O_CKVF + al256((size_t)NPR * 256 * 4);
constexpr size_t O_GMLA = O_CKVSS + al256((size_t)NTOK * 4 * 4);
constexpr size_t O_HQ = O_GMLA + al256((size_t)NTOK * 512 * 2);
constexpr size_t O_LFF = O_HQ + (size_t)NTOK * 512 * 4;
constexpr size_t O_LFB = O_LFF + (size_t)NTOK * 512 * 4;
constexpr size_t O_HV = O_LFB + (size_t)NTOK * 512 * 4;
constexpr size_t O_GHG = O_HV + (size_t)NTOK * 512 * 4;
constexpr size_t O_SIG = O_GHG + al256((size_t)NTOK * 512 * 2);
constexpr size_t O_KRF = O_SIG + al256((size_t)NTOK * 6144 * 2);
constexpr size_t O_QM = O_KRF + al256((size_t)NTOK * 32 * 4);
constexpr size_t O_KNP = O_QM + al256((size_t)NTOK * 768 * 2);
constexpr size_t O_KRP = O_KNP + al256((size_t)NPR * 512 * 2);
constexpr size_t O_VTMP = O_KRP + al256((size_t)NPR * 32 * 2);
constexpr size_t O_OBR = O_VTMP + al256((size_t)NPR * 512 * 2);
constexpr size_t O_OPART = O_OBR + al256((size_t)3 * NTOK * 512 * 2);
constexpr size_t O_SGRP = O_OPART + al256((size_t)2 * NTOK * 512 * 4);
constexpr size_t O_DGRP = O_SGRP + al256((size_t)1536 * 4096 * 4);
constexpr size_t O_OSS = O_DGRP + al256((size_t)1536 * 64 * 4);
constexpr size_t O_OTMP = O_OSS + al256((size_t)NTOK * 32 * 4);
constexpr size_t O_GST = O_OTMP + al256((size_t)NTOK * 512 * 4);
constexpr size_t WS_END = O_GST + al256((size_t)512 * 4096 * 4);
constexpr size_t O_CTL = WS_END, O_CNT = O_CTL + 16384, CTL_BYTES = 16384 + 96 * 256;
constexpr size_t WS_TOTAL = O_CTL + CTL_BYTES;
static_assert(WS_TOTAL < (size_t)780 * 1024 * 1024, "workspace map too large");
constexpr size_t O_PMRG = O_HQ, O_MERGED = O_H, O_OUTB = O_HQ;
constexpr size_t O_QE = O_H;
static_assert((size_t)2 * NTOK * 512 * 4 <= (size_t)NTOK * DM * 2, "QE overlay");

constexpr size_t OUT_YP = 0, OUT_YS = OUT_YP + (size_t)NPR * DM, OUT_NK = OUT_YS + (size_t)NSM * DM, OUT_NV = OUT_NK + (size_t)32 * 2 * 256 * 512,
                 OUT_CKV = OUT_NV + (size_t)32 * 2 * 256 * 512, OUT_KR = OUT_CKV + (size_t)32 * 2 * 256 * 256, OUT_SF = OUT_KR + (size_t)32 * 2 * 256 * 32,
                 OUT_SB = OUT_SF + (size_t)32 * 2 * 8 * 4096, OUT_END = OUT_SB + (size_t)32 * 2 * 8 * 4096;

struct Params {
    const float* in[27];
    float* out;
    unsigned char* ws;
};
enum { I_XP = 0, I_XS, I_CNK, I_CNV, I_CCKV, I_CKR, I_SF, I_SB, I_C, I_CCTX, I_WADA, I_BADA, I_GPRE, I_GPOST, I_WIN, I_RPB, I_GMQ, I_WUQ, I_GMKV, I_WUKV,
       I_LBF, I_LBB, I_GHG, I_WBNA, I_WBMLA, I_WBHG, I_WOUT };

namespace pg8 {
#define PG8_LAS __attribute__((address_space(3)))
constexpr int BM = 256, BK = 64, HALF = 128, HTB = HALF * BK * 2, STAGE_BYTES = 8 * HTB, NXCD = 8, WGM = 8;
__host__ __device__ __forceinline__ int lds_byte(int r, int c) { const int st = (r >> 4) * 2 + (c >> 5), rr = r & 15, cc = c & 31, ob = rr * 64 + cc * 2; return st * 1024 + (ob ^ (((ob >> 9) & 1) << 5)); }
__host__ __device__ __forceinline__ void stage_rc(int b, int& R, int& C) { const int st = b / 1024, sb = b % 1024, swz = sb ^ (((sb >> 9) & 1) << 5); R = (st >> 1) * 16 + swz / 64; C = (st & 1) * 32 + (swz % 64) / 2; }
__host__ __device__ __forceinline__ int perm32(int rho) { const int n = rho >> 4, i = rho & 15; return 8 * (i >> 2) + 4 * n + (i & 3); }
struct Unit { int pm, pn, br; };
struct Gemm { const bf16_t* A; const bf16_t* Bt; int M, N, K; size_t a_br, b_br; };
struct StaticOrder {
    int nM, nN, nwg, G, c, nbr;
    __device__ void init(int M, int N, int G_, int c_, int nbr_) { nM = M / BM; nN = N / BM; nwg = nM * nN; G = G_; c = c_; nbr = nbr_; }
    __device__ bool next(int i, Unit& u) const {
        const int it = i / nbr; u.br = i - it * nbr;
        const long L = (long)it * G + c; if (L >= nwg) return false;
        int wgid = (int)L; { const int q = nwg / NXCD, r = nwg % NXCD, xcd = wgid % NXCD, off = wgid / NXCD; wgid = (xcd < r ? xcd * (q + 1) : r * (q + 1) + (xcd - r) * q) + off; }
        const int nig = WGM * nN, gid = wgid / nig, fm = gid * WGM, gsz = (nM - fm) < WGM ? (nM - fm) : WGM;
        u.pm = fm + ((wgid % nig) % gsz); u.pn = (wgid % nig) / gsz; return true;
    }
    __device__ __forceinline__ void a_ready(const Unit&) const {}
    __device__ __forceinline__ void done(const Unit&) const {}
};
struct CountedOrder : StaticOrder {
    const unsigned* ready; unsigned need; int pm0, wid;
    __device__ __forceinline__ void a_ready(const Unit& u) const {
        if (wid == 0) {
            const unsigned* p = ready + 64 * (pm0 + u.pm); unsigned polls = 0;
            while ((unsigned)__builtin_amdgcn_readfirstlane(__hip_atomic_load(p, __ATOMIC_RELAXED, __HIP_MEMORY_SCOPE_AGENT)) < need) { __builtin_amdgcn_s_sleep(2); if (++polls > (1u << 22)) break; }
            __builtin_amdgcn_fence(__ATOMIC_ACQUIRE, "agent");
            asm volatile("s_waitcnt vmcnt(0)" ::: "memory");
        }
        asm volatile("" ::: "memory"); __builtin_amdgcn_s_barrier(); asm volatile("" ::: "memory");
    }
};
template <class Epi, class Sched>
__device__ __forceinline__ void gemm_phase(PG8_LAS unsigned char* lds, const Gemm g, const Sched& S, const Epi& E, const int wid_in) {
    const int wid = wid_in, lane = lane_id(), tid = wid * 64 + lane, wr = wid >> 2, wc = wid & 3, fr = lane & 15, fq = lane >> 4;
    const int K = g.K, nt = K / BK;
    unsigned voffA[2], voffB[2];
#pragma unroll
    for (int i = 0; i < 2; ++i) { int R, C; stage_rc(tid * 16 + i * 8192, R, C); const int Rb = Epi::PERM ? ((R & ~31) + perm32(R & 31)) : R;
        voffA[i] = (unsigned)(R * K + C) * 2u; voffB[i] = (unsigned)(Rb * K + C) * 2u; }
    const size_t kstep = (size_t)(BK * 2);
    const size_t hstep = (size_t)HALF * K * 2;
    const size_t tstep = 2 * hstep;
    const unsigned ldsw = (unsigned)wid * 1024u;
    const int aoff = lds_byte(wr * 64 + fr, fq * 8), boff = lds_byte(wc * 32 + fr, fq * 8);
#define PG8_SA(b, h) (((b) * 2 + (h)) * HTB)
#define PG8_SB(b, h) ((4 + (b) * 2 + (h)) * HTB)
#define PG8_STAGE(bufoff, gbase, voff) do { _Pragma("unroll") for (int _i = 0; _i < 2; ++_i) \
        __builtin_amdgcn_global_load_lds((const unsigned*)((const char*)(gbase) + (voff)[_i]), (PG8_LAS unsigned*)(lds + (bufoff) + ldsw + _i * 8192), 16, 0, 0); } while (0)
#define PG8_LDA(dst, b, h) do { _Pragma("unroll") for (int m = 0; m < 4; ++m) _Pragma("unroll") for (int k = 0; k < 2; ++k) dst[m][k] = *(const PG8_LAS bf16x8*)(lds + PG8_SA(b, h) + aoff + m * 2048 + k * 1024); } while (0)
#define PG8_LDB(dst, b, h) do { _Pragma("unroll") for (int n = 0; n < 2; ++n) _Pragma("unroll") for (int k = 0; k < 2; ++k) dst[n][k] = *(const PG8_LAS bf16x8*)(lds + PG8_SB(b, h) + boff + n * 2048 + k * 1024); } while (0)
#define PG8_MMA(ai, bj, At, Bt) do { __builtin_amdgcn_s_setprio(1); _Pragma("unroll") for (int m = 0; m < 4; ++m) _Pragma("unroll") for (int n = 0; n < 2; ++n) _Pragma("unroll") for (int k = 0; k < 2; ++k) \
        acc[ai][bj][m][n] = __builtin_amdgcn_mfma_f32_16x16x32_bf16(Bt[n][k], At[m][k], acc[ai][bj][m][n], 0, 0, 0); __builtin_amdgcn_s_setprio(0); } while (0)
#define PG8_WAIT_V(n) asm volatile("s_waitcnt vmcnt(" #n ")" ::: "memory")
#define PG8_WAIT_L(n) asm volatile("s_waitcnt lgkmcnt(" #n ")" ::: "memory")
#define PG8_BAR __builtin_amdgcn_s_barrier()
#define PG8_SCHED __builtin_amdgcn_sched_barrier(0)
    Unit cur, nxt; int ui = 0;
    if (!S.next(0, cur)) return;
    f32x4 acc[2][2][4][2];
#pragma unroll
    for (int a = 0; a < 2; ++a)
#pragma unroll
        for (int b = 0; b < 2; ++b)
#pragma unroll
            for (int m = 0; m < 4; ++m)
#pragma unroll
                for (int n = 0; n < 2; ++n) acc[a][b][m][n] = (f32x4){0.f, 0.f, 0.f, 0.f};
    bf16x8 At[4][2], B0[2][2], B1[2][2];
    const char* cA = (const char*)g.A + (size_t)cur.pm * tstep + (size_t)cur.br * g.a_br; const char* cB = (const char*)g.Bt + (size_t)cur.pn * tstep + (size_t)cur.br * g.b_br;
    S.a_ready(cur);
    PG8_STAGE(PG8_SB(0, 0), cB, voffB); PG8_STAGE(PG8_SA(0, 0), cA, voffA); PG8_STAGE(PG8_SB(0, 1), cB + hstep, voffB); PG8_STAGE(PG8_SA(0, 1), cA + hstep, voffA);
    if (wr == 1) PG8_BAR;
    PG8_WAIT_V(4); PG8_BAR;
    PG8_STAGE(PG8_SB(1, 0), cB + kstep, voffB); PG8_STAGE(PG8_SA(1, 0), cA + kstep, voffA); PG8_STAGE(PG8_SB(1, 1), cB + hstep + kstep, voffB);
    PG8_WAIT_V(6); PG8_BAR;
    for (;;) {
        const bool has_next = S.next(ui + 1, nxt);
        const char* nA = has_next ? (const char*)g.A + (size_t)nxt.pm * tstep + (size_t)nxt.br * g.a_br : cA; const char* nB = has_next ? (const char*)g.Bt + (size_t)nxt.pn * tstep + (size_t)nxt.br * g.b_br : cB;
        for (int t = 0; t < nt; t += 2) {
            const bool last = (t == nt - 2);
            const char* a1 = cA + (size_t)(t + 1) * kstep;
            const char* a2 = last ? nA : cA + (size_t)(t + 2) * kstep; const char* b2 = last ? nB : cB + (size_t)(t + 2) * kstep;
            const char* a3 = a2 + kstep; const char* b3 = b2 + kstep;
            if (last && has_next) S.a_ready(nxt);
            PG8_LDB(B0, 0, 0); PG8_SCHED; PG8_LDA(At, 0, 0); PG8_STAGE(PG8_SA(1, 1), a1 + hstep, voffA);
            PG8_WAIT_L(8); PG8_BAR; PG8_WAIT_L(0); PG8_MMA(0, 0, At, B0); PG8_BAR; PG8_SCHED;
            PG8_LDB(B1, 0, 1); PG8_STAGE(PG8_SB(0, 0), b2, voffB);
            PG8_BAR; PG8_WAIT_L(0); PG8_MMA(0, 1, At, B1); PG8_BAR;
            PG8_LDA(At, 0, 1); PG8_STAGE(PG8_SA(0, 0), a2, voffA);
            PG8_BAR; PG8_WAIT_L(0); PG8_MMA(1, 0, At, B0); PG8_BAR; PG8_SCHED;
            PG8_STAGE(PG8_SB(0, 1), b2 + hstep, voffB);
            PG8_WAIT_V(6); PG8_BAR; PG8_MMA(1, 1, At, B1); PG8_BAR;
            PG8_LDB(B0, 1, 0); PG8_SCHED; PG8_LDA(At, 1, 0); PG8_STAGE(PG8_SA(0, 1), a2 + hstep, voffA);
            PG8_WAIT_L(8); PG8_BAR; PG8_WAIT_L(0); PG8_MMA(0, 0, At, B0); PG8_BAR; PG8_SCHED;
            PG8_LDB(B1, 1, 1); PG8_STAGE(PG8_SB(1, 0), b3, voffB);
            PG8_BAR; PG8_WAIT_L(0); PG8_MMA(0, 1, At, B1); PG8_BAR;
            PG8_LDA(At, 1, 1); PG8_STAGE(PG8_SA(1, 0), a3, voffA);
            PG8_BAR; PG8_WAIT_L(0); PG8_MMA(1, 0, At, B0); PG8_BAR; PG8_SCHED;
            PG8_STAGE(PG8_SB(1, 1), b3 + hstep, voffB);
            PG8_WAIT_V(6); PG8_BAR; PG8_MMA(1, 1, At, B1); PG8_BAR;
        }
        if constexpr (!Epi::AFTER_DRAIN) { E(acc, cur, wr, wc, fr, fq); S.done(cur); }
        if (!has_next) break;
        if constexpr (!Epi::KEEP_ACC)
#pragma unroll
        for (int a = 0; a < 2; ++a)
#pragma unroll
            for (int b = 0; b < 2; ++b)
#pragma unroll
                for (int m = 0; m < 4; ++m)
#pragma unroll
                    for (int n = 0; n < 2; ++n) acc[a][b][m][n] = (f32x4){0.f, 0.f, 0.f, 0.f};
        cur = nxt; cA = nA; cB = nB; ++ui;
    }
    PG8_WAIT_V(0);
    if (wr == 0) PG8_BAR;
    PG8_BAR;
    if constexpr (Epi::AFTER_DRAIN) { E.fused(acc, cur, wr, wc, fr, fq, lds, wid, lane); S.done(cur); }
#undef PG8_SA
#undef PG8_SB
#undef PG8_STAGE
#undef PG8_LDA
#undef PG8_LDB
#undef PG8_MMA
#undef PG8_WAIT_V
#undef PG8_WAIT_L
#undef PG8_BAR
#undef PG8_SCHED
}
}

#define EPI_LOOP(...) \
    _Pragma("unroll") for (int ai = 0; ai < 2; ++ai) _Pragma("unroll") for (int m = 0; m < 4; ++m) { const int rl = ai * 128 + rl0 + m * 16; const int r = pm * 256 + rl; (void)r; \
    _Pragma("unroll") for (int bj = 0; bj < 2; ++bj) { const int ct = bj * 128 + cw; const f32x4 v0 = acc[ai][bj][m][0], v1 = acc[ai][bj][m][1]; __VA_ARGS__ } asm volatile("" ::: "memory"); }
#define PK8(w, a0, a1, a2, a3, a4, a5, a6, a7) u32x4 w; w.x = pk2(a0, a1); w.y = pk2(a2, a3); w.z = pk2(a4, a5); w.w = pk2(a6, a7);

DI float gate_logf(float z, float lb) { return __logf(lb + (1.f - lb) * sigmoidf_(z)); }
template <class T> DI T* at(const void* base, unsigned byteoff) { return (T*)((unsigned char*)base + byteoff); }

struct EpiIn {
    static constexpr bool PERM = true, AFTER_DRAIN = false, KEEP_ACC = false;
    unsigned char* ws; float* out; int layer; const float* lbf; const float* lbb;
    DI void operator()(const f32x4 (&acc)[2][2][4][2], const pg8::Unit& u, int wr, int wc, int, int) const {
        const int l_ = lane_id(); const int fr = l_ & 15, fq = l_ >> 4;
        const int pn = u.pn, pm = u.pm; const int rl0 = wr * 64 + fr, cw = wc * 32 + fq * 8;
        const bool prompt = pm < 32;
        if (pn < 2) {
            bf16_t* QA = (bf16_t*)(ws + O_QA);
            EPI_LOOP({ PK8(w, v0[0] * QS_NA, v0[1] * QS_NA, v0[2] * QS_NA, v0[3] * QS_NA, v1[0] * QS_NA, v1[1] * QS_NA, v1[2] * QS_NA, v1[3] * QS_NA)
                       *(u32x4*)(QA + (size_t)r * 512 + pn * 256 + ct) = w; })
        } else if (pn < 4) {
            bf16_t* KA = (bf16_t*)(ws + O_KA);
            EPI_LOOP({ PK8(w, v0[0], v0[1], v0[2], v0[3], v1[0], v1[1], v1[2], v1[3])
                       *(u32x4*)(KA + (size_t)r * 512 + (pn - 2) * 256 + ct) = w;
                       if (prompt) { float* o = out + OUT_NK + ((size_t)(pm * 2 + layer) * 256 + rl) * 512 + (pn - 2) * 256 + ct; __builtin_nontemporal_store(v0, (f32x4*)o); __builtin_nontemporal_store(v1, (f32x4*)(o + 4)); } })
        } else if (pn < 6) {
            bf16_t* VTA = (bf16_t*)(ws + O_VTA);
            EPI_LOOP({ const int c0 = (pn - 4) * 256 + ct, head = c0 >> 6, dv0 = c0 & 63;
                       bf16_t* p; size_t st;
                       if (prompt) { p = VTA + ((size_t)(pm * 8 + head) * 64 + dv0) * 256 + rl; st = 256; }
                       else { const int bs = (pm - 32) >> 3, ts = ((pm - 32) & 7) * 256 + rl; p = VTA + (size_t)4194304 + ((size_t)(bs * 8 + head) * 64 + dv0) * 2048 + ts; st = 2048; }
                       p[0] = f2bf(v0[0]); p[st] = f2bf(v0[1]); p[2 * st] = f2bf(v0[2]); p[3 * st] = f2bf(v0[3]);
                       p[4 * st] = f2bf(v1[0]); p[5 * st] = f2bf(v1[1]); p[6 * st] = f2bf(v1[2]); p[7 * st] = f2bf(v1[3]);
                       if (prompt) { float* o = out + OUT_NV + ((size_t)(pm * 2 + layer) * 256 + rl) * 512 + c0; __builtin_nontemporal_store(v0, (f32x4*)o); __builtin_nontemporal_store(v1, (f32x4*)(o + 4)); } })
        } else if (pn < 8) {
            bf16_t* G = (bf16_t*)(ws + O_GNA);
            EPI_LOOP({ PK8(w, siluf_(v0[0]), siluf_(v0[1]), siluf_(v0[2]), siluf_(v0[3]), siluf_(v1[0]), siluf_(v1[1]), siluf_(v1[2]), siluf_(v1[3]))
                       *(u32x4*)(G + (size_t)r * 512 + (pn - 6) * 256 + ct) = w; })
        } else if (pn < 11) {
            bf16_t* CQ = (bf16_t*)(ws + O_CQ); bf16_t* CKVB = (bf16_t*)(ws + O_CKVB); float* CKVF = (float*)(ws + O_CKVF);
            float* CQSS = (float*)(ws + O_CQSS); float* CKVSS = (float*)(ws + O_CKVSS);
#pragma unroll
            for (int ai = 0; ai < 2; ++ai)
#pragma unroll
                for (int m = 0; m < 4; ++m) {
                    const int rl = ai * 128 + rl0 + m * 16; const int r = pm * 256 + rl; float s = 0.f;
#pragma unroll
                    for (int bj = 0; bj < 2; ++bj) {
                        const int ct = bj * 128 + cw; const f32x4 v0 = acc[ai][bj][m][0], v1 = acc[ai][bj][m][1];
                        s += (v0[0] * v0[0] + v0[1] * v0[1]) + (v0[2] * v0[2] + v0[3] * v0[3]) + (v1[0] * v1[0] + v1[1] * v1[1]) + (v1[2] * v1[2] + v1[3] * v1[3]);
                        PK8(w, v0[0], v0[1], v0[2], v0[3], v1[0], v1[1], v1[2], v1[3])
                        if (pn < 10) *(u32x4*)(CQ + (size_t)r * 512 + (pn - 8) * 256 + ct) = w;
                        else { *(u32x4*)(CKVB + (size_t)r * 256 + ct) = w; if (prompt) { float* o = CKVF + (size_t)r * 256 + ct; *(f32x4*)o = v0; *(f32x4*)(o + 4) = v1; } }
                    }
                    s += xor_swz<16>(s); s = sum_x32(s);
                    if (fq == 0) { if (pn < 10) CQSS[(size_t)r * 8 + (pn - 8) * 4 + wc] = s; else CKVSS[(size_t)r * 4 + wc] = s; }
                }
        } else if (pn < 13) {
            bf16_t* G = (bf16_t*)(ws + O_GMLA);
            EPI_LOOP({ PK8(w, siluf_(v0[0]), siluf_(v0[1]), siluf_(v0[2]), siluf_(v0[3]), siluf_(v1[0]), siluf_(v1[1]), siluf_(v1[2]), siluf_(v1[3]))
                       *(u32x4*)(G + (size_t)r * 512 + (pn - 11) * 256 + ct) = w; })
        } else if (pn < 15) {
            float* HQ = (float*)(ws + O_HQ);
            EPI_LOOP({ float* o = HQ + (size_t)r * 512 + (pn - 13) * 256 + ct;
                       *(f32x4*)o = (f32x4){siluf_(v0[0]), siluf_(v0[1]), siluf_(v0[2]), siluf_(v0[3])}; *(f32x4*)(o + 4) = (f32x4){siluf_(v1[0]), siluf_(v1[1]), siluf_(v1[2]), siluf_(v1[3])}; })
        } else if (pn < 19) {
            const bool fwd = pn < 17; const int pb = fwd ? 15 : 17;
            float* LF = (float*)(ws + (fwd ? O_LFF : O_LFB)); const float* lbp = fwd ? lbf : lbb; const bool has_lb = layer > 0;
            float lbv[2][8];
#pragma unroll
            for (int bj = 0; bj < 2; ++bj)
#pragma unroll
                for (int e = 0; e < 8; ++e) { const int col = (pn - pb) * 256 + bj * 128 + cw + e; lbv[bj][e] = has_lb ? sigmoidf_(lbp[512 + col] - lbp[col]) : 0.f; }
            EPI_LOOP({ float* o = LF + (size_t)r * 512 + (pn - pb) * 256 + ct;
                       *(f32x4*)o = (f32x4){gate_logf(v0[0], lbv[bj][0]), gate_logf(v0[1], lbv[bj][1]), gate_logf(v0[2], lbv[bj][2]), gate_logf(v0[3], lbv[bj][3])};
                       *(f32x4*)(o + 4) = (f32x4){gate_logf(v1[0], lbv[bj][4]), gate_logf(v1[1], lbv[bj][5]), gate_logf(v1[2], lbv[bj][6]), gate_logf(v1[3], lbv[bj][7])}; })
        } else if (pn < 21) {
            float* HV = (float*)(ws + O_HV);
            EPI_LOOP({ float* o = HV + (size_t)r * 512 + (pn - 19) * 256 + ct; *(f32x4*)o = v0; *(f32x4*)(o + 4) = v1; })
        } else if (pn < 23) {
            bf16_t* G = (bf16_t*)(ws + O_GHG);
            EPI_LOOP({ PK8(w, siluf_(v0[0]), siluf_(v0[1]), siluf_(v0[2]), siluf_(v0[3]), siluf_(v1[0]), siluf_(v1[1]), siluf_(v1[2]), siluf_(v1[3]))
                       *(u32x4*)(G + (size_t)r * 512 + (pn - 21) * 256 + ct) = w; })
        } else if (pn < 47) {
            EPI_LOOP({ const f32x4 s0 = (f32x4){sigmoidf_(v0[0]), sigmoidf_(v0[1]), sigmoidf_(v0[2]), sigmoidf_(v0[3])} * 255.f + 0.5f, s1 = (f32x4){sigmoidf_(v1[0]), sigmoidf_(v1[1]), sigmoidf_(v1[2]), sigmoidf_(v1[3])} * 255.f + 0.5f;
                       u32x2 w; w.x = max((unsigned)s0[0], 1u) | (max((unsigned)s0[1], 1u) << 8) | (max((unsigned)s0[2], 1u) << 16) | (max((unsigned)s0[3], 1u) << 24);
                       w.y = max((unsigned)s1[0], 1u) | (max((unsigned)s1[1], 1u) << 8) | (max((unsigned)s1[2], 1u) << 16) | (max((unsigned)s1[3], 1u) << 24);
                       *at<u32x2>(ws, (unsigned)O_SIG + (unsigned)(r * 6144 + (pn - 23) * 256 + ct)) = w; })
        } else {
            float* KRF = (float*)(ws + O_KRF);
            if (wc == 0) {
                EPI_LOOP({ if (bj == 0) { float* o = KRF + (size_t)r * 32 + ct; *(f32x4*)o = v0; *(f32x4*)(o + 4) = v1; } })
            }
        }
    }
};

struct EpiUQ {
    static constexpr bool PERM = true, AFTER_DRAIN = false, KEEP_ACC = false;
    unsigned char* ws;
    DI void operator()(const f32x4 (&acc)[2][2][4][2], const pg8::Unit& u, int wr, int wc, int, int) const {
        const int l_ = lane_id(); const int fr = l_ & 15, fq = l_ >> 4;
        const int pn = u.pn, pm = u.pm; const int rl0 = wr * 64 + fr, cw = wc * 32 + fq * 8;
        const float* CQSS = (const float*)(ws + O_CQSS); const float* ROPE = (const float*)(ws + O_ROPE); bf16_t* QM = (bf16_t*)(ws + O_QM);
        const bool sample = pm >= 32;
#pragma unroll
        for (int ai = 0; ai < 2; ++ai)
#pragma unroll
            for (int m = 0; m < 4; ++m) {
                const int rl = ai * 128 + rl0 + m * 16; const int r = pm * 256 + rl;
                const f32x4 sa = *(const f32x4*)(CQSS + (size_t)r * 8), sb = *(const f32x4*)(CQSS + (size_t)r * 8 + 4);
                const float rs = rsqrtf(((sa[0] + sa[1]) + (sa[2] + sa[3]) + (sb[0] + sb[1]) + (sb[2] + sb[3])) * (1.f / 512.f) + EPS) * QS_MLA;
#pragma unroll
                for (int bj = 0; bj < 2; ++bj) {
                    const int ct = bj * 128 + cw; const f32x4 v0 = acc[ai][bj][m][0], v1 = acc[ai][bj][m][1];
                    float x[8] = {v0[0] * rs, v0[1] * rs, v0[2] * rs, v0[3] * rs, v1[0] * rs, v1[1] * rs, v1[2] * rs, v1[3] * rs};
                    const int gid = pn * 8 + bj * 4 + wc;
                    if (sample && (gid % 3 == 2)) {
                        const int ts = ((pm - 32) & 7) * 256 + rl; const int pos = (fq >> 1) ? (ts & 63) : (ts >> 6); const bool half = fq & 1;
                        const float* tb = ROPE + pos * 16;
                        const f32x4 t0 = *(const f32x4*)tb, t1 = *(const f32x4*)(tb + 4), t2 = *(const f32x4*)(tb + 8), t3 = *(const f32x4*)(tb + 12);
                        const float cs[8] = {t0[0], t0[2], t1[0], t1[2], t2[0], t2[2], t3[0], t3[2]}, sn[8] = {t0[1], t0[3], t1[1], t1[3], t2[1], t2[3], t3[1], t3[3]};
#pragma unroll
                        for (int e = 0; e < 8; ++e) { const float pr = xor_swz<16>(x[e]); x[e] = x[e] * cs[e] + (half ? pr : -pr) * sn[e]; }
                    }
                    PK8(w, x[0], x[1], x[2], x[3], x[4], x[5], x[6], x[7])
                    *(u32x4*)(QM + (size_t)r * 768 + pn * 256 + ct) = w;
                }
            }
    }
};

struct EpiKV {
    static constexpr bool PERM = true, AFTER_DRAIN = false, KEEP_ACC = false;
    unsigned char* ws; int layer; int ctx;
    DI void operator()(const f32x4 (&acc)[2][2][4][2], const pg8::Unit& u, int wr, int wc, int, int) const {
        const int l_ = lane_id(); const int fr = l_ & 15, fq = l_ >> 4;
        const int pn = u.pn, pm = u.pm; const int rl0 = wr * 64 + fr, fq8 = fq * 8;
        unsigned kbase, vbase; int vst;
        if (ctx) { const int b = pm >> 1, t0 = (pm & 1) * 256; kbase = (unsigned)O_KNS + (unsigned)(((layer * 2 + b) * 2560 + t0) * 1024); vbase = (unsigned)O_VTMS + (unsigned)(((layer * 2 + b) * 8 * 64 * 2560 + t0) * 2); vst = 2560; }
        else if (pm < 32) { kbase = (unsigned)O_KNP + (unsigned)(pm * 256 * 1024); vbase = (unsigned)O_VTMP + (unsigned)(pm * 8 * 64 * 256 * 2); vst = 256; }
        else { const int bs = (pm - 32) >> 3, t0 = 512 + ((pm - 32) & 7) * 256; kbase = (unsigned)O_KNS + (unsigned)(((layer * 2 + bs) * 2560 + t0) * 1024); vbase = (unsigned)O_VTMS + (unsigned)(((layer * 2 + bs) * 8 * 64 * 2560 + t0) * 2); vst = 2560; }
#pragma unroll
        for (int ai = 0; ai < 2; ++ai)
#pragma unroll
            for (int m = 0; m < 4; ++m) {
                const int rl = ai * 128 + rl0 + m * 16;
                float rs = 1.f;
                if (!ctx) { const f32x4 sa = *at<const f32x4>(ws, (unsigned)O_CKVSS + (unsigned)((pm * 256 + rl) * 16)); rs = rsqrtf(((sa[0] + sa[1]) + (sa[2] + sa[3])) * (1.f / 256.f) + EPS); }
#pragma unroll
                for (int bj = 0; bj < 2; ++bj) {
                    const f32x4 v0 = acc[ai][bj][m][0] * rs, v1 = acc[ai][bj][m][1] * rs;
                    const int gid = pn * 8 + bj * 4 + wc, head = gid >> 2, part = gid & 3;
                    if (part < 2) { PK8(w, v0[0], v0[1], v0[2], v0[3], v1[0], v1[1], v1[2], v1[3]) *at<u32x4>(ws, kbase + (unsigned)(rl * 1024 + (head * 64 + part * 32 + fq8) * 2)) = w; }
                    else { const unsigned sb = (unsigned)(vst * 2); unsigned o = vbase + (unsigned)(rl * 2) + (unsigned)(head * 64 + (part - 2) * 32 + fq8) * sb;
                        *at<bf16_t>(ws, o) = f2bf(v0[0]); *at<bf16_t>(ws, o + sb) = f2bf(v0[1]); *at<bf16_t>(ws, o + 2 * sb) = f2bf(v0[2]); *at<bf16_t>(ws, o + 3 * sb) = f2bf(v0[3]);
                        *at<bf16_t>(ws, o + 4 * sb) = f2bf(v1[0]); *at<bf16_t>(ws, o + 5 * sb) = f2bf(v1[1]); *at<bf16_t>(ws, o + 6 * sb) = f2bf(v1[2]); *at<bf16_t>(ws, o + 7 * sb) = f2bf(v1[3]); }
                }
                asm volatile("" ::: "memory");
            }
    }
};

DI f32x4 ub4(unsigned w) { return (f32x4){(float)(w & 255u), (float)((w >> 8) & 255u), (float)((w >> 16) & 255u), (float)(w >> 24)}; }
struct EpiMerge {
    static constexpr bool PERM = true, AFTER_DRAIN = false, KEEP_ACC = true;
    unsigned char* ws; int pm0; unsigned* cnt;
    DI void operator()(f32x4 (&acc)[2][2][4][2], const pg8::Unit& u, int wr, int wc, int, int) const {
        const int l_ = lane_id(); const int fr = l_ & 15, fq = l_ >> 4;
        const int pn = u.pn, pm = u.pm + pm0, br = u.br; const int rl0 = wr * 64 + fr, cw = wc * 32 + fq * 8;
        const unsigned sbase = (unsigned)O_SIG + (unsigned)((pm * 256 + rl0) * 6144 + br * 2048 + pn * 256 + cw);
        const unsigned mbase = (unsigned)O_MERGED + (unsigned)((pm * 256 + rl0) * 4096 + (pn * 256 + cw) * 2);
        u32x2 sg[2][4][2], sn[2][4][2];
#pragma unroll
        for (int ai = 0; ai < 2; ++ai)
#pragma unroll
            for (int m = 0; m < 4; ++m)
#pragma unroll
                for (int bj = 0; bj < 2; ++bj) {
                    sg[ai][m][bj] = *at<const u32x2>(ws, sbase + (unsigned)((ai * 128 + m * 16) * 6144 + bj * 128));
                    if (br < 2) sn[ai][m][bj] = *at<const u32x2>(ws, sbase + (unsigned)((ai * 128 + m * 16) * 6144 + bj * 128 + 2048));
                    else sn[ai][m][bj] = (u32x2){0x01010101u, 0x01010101u};
                }
#pragma unroll
        for (int ai = 0; ai < 2; ++ai)
#pragma unroll
            for (int m = 0; m < 4; ++m)
#pragma unroll
                for (int bj = 0; bj < 2; ++bj) {
                    const u32x2 s2 = sg[ai][m][bj], n2 = sn[ai][m][bj];
                    const f32x4 a = ub4(s2.x) * acc[ai][bj][m][0], b = ub4(s2.y) * acc[ai][bj][m][1];
                    if (br < 2) {
                        const f32x4 na = ub4(n2.x), nb = ub4(n2.y);
                        acc[ai][bj][m][0] = a * (f32x4){__builtin_amdgcn_rcpf(na[0]), __builtin_amdgcn_rcpf(na[1]), __builtin_amdgcn_rcpf(na[2]), __builtin_amdgcn_rcpf(na[3])};
                        acc[ai][bj][m][1] = b * (f32x4){__builtin_amdgcn_rcpf(nb[0]), __builtin_amdgcn_rcpf(nb[1]), __builtin_amdgcn_rcpf(nb[2]), __builtin_amdgcn_rcpf(nb[3])};
                    } else {
                        const f32x4 a1 = a * (1.f / 255.f), b1 = b * (1.f / 255.f);
                        PK8(w, a1[0], a1[1], a1[2], a1[3], b1[0], b1[1], b1[2], b1[3])
                        { u32x4* mp_ = at<u32x4>(ws, mbase + (unsigned)((ai * 128 + m * 16) * 4096 + bj * 256)); asm volatile("global_store_dwordx4 %0, %1, off sc0 sc1" :: "v"(mp_), "v"(w) : "memory"); }
                        acc[ai][bj][m][0] = (f32x4){0.f, 0.f, 0.f, 0.f}; acc[ai][bj][m][1] = (f32x4){0.f, 0.f, 0.f, 0.f};
                    }
                }
        if (br == 2) {
            asm volatile("s_waitcnt vmcnt(0)" ::: "memory");
            if (l_ == 0) __hip_atomic_fetch_add(cnt + 64 * pm, 1u, __ATOMIC_RELAXED, __HIP_MEMORY_SCOPE_AGENT);
        }
    }
};

struct EpiOut {
    static constexpr bool PERM = true, AFTER_DRAIN = false, KEEP_ACC = false;
    unsigned char* ws; int pm0;
    DI void operator()(const f32x4 (&acc)[2][2][4][2], const pg8::Unit& u, int wr, int wc, int, int) const {
        const int l_ = lane_id(); const int fr = l_ & 15, fq = l_ >> 4;
        const int pn = u.pn, pm = u.pm + pm0; const int rl0 = wr * 64 + fr, cw = wc * 32 + fq * 8;
        bf16_t* OB = (bf16_t*)(ws + O_OUTB); float* OSS = (float*)(ws + O_OSS);
#pragma unroll
        for (int ai = 0; ai < 2; ++ai)
#pragma unroll
            for (int m = 0; m < 4; ++m) {
                const int rl = ai * 128 + rl0 + m * 16; const int r = pm * 256 + rl; float s = 0.f;
#pragma unroll
                for (int bj = 0; bj < 2; ++bj) {
                    const int ct = bj * 128 + cw; const f32x4 v0 = acc[ai][bj][m][0], v1 = acc[ai][bj][m][1];
                    s += (v0[0] * v0[0] + v0[1] * v0[1]) + (v0[2] * v0[2] + v0[3] * v0[3]) + (v1[0] * v1[0] + v1[1] * v1[1]) + (v1[2] * v1[2] + v1[3] * v1[3]);
                    PK8(w, v0[0], v0[1], v0[2], v0[3], v1[0], v1[1], v1[2], v1[3])
                    *(u32x4*)(OB + (size_t)r * 2048 + pn * 256 + ct) = w;
                }
                s += xor_swz<16>(s); s = sum_x32(s);
                if (fq == 0) OSS[(size_t)r * 32 + pn * 4 + wc] = s;
            }
    }
};

constexpr int LDS_BYTES = 147456;
constexpr int KSTR = 208, VSTR = 144;
constexpr int A_K0 = 0, A_K1 = 64 * KSTR, A_V0 = 2 * 64 * KSTR, A_V1 = A_V0 + 64 * VSTR, A_MRG = A_V0 + 2 * 64 * VSTR;
static_assert(A_MRG + 4 * 34 * 64 * 4 <= 98304, "attention LDS map");
constexpr int HG_SCR = 98304;

constexpr int GV_SV = 73728, GV_PART = GV_SV + 3 * 2048 * 4;
static_assert(GV_PART + 8 * 3 * 256 * 4 <= LDS_BYTES, "gemv LDS map");
#define LDSW() asm volatile("s_waitcnt lgkmcnt(0)" ::: "memory")
#define MFMA32(a, b, c) __builtin_amdgcn_mfma_f32_32x32x16_bf16((a), (b), (c), 0, 0, 0)

constexpr int LDS_BAR = LDS_BYTES - 64;
#define XB_TMO      128
#define XB_XCNT(j)  (256  + 64 * (j))
#define XB_XSUB(j)  (1280 + 64 * (j))
#define XB_XGEN(j)  (2304 + 64 * (j))
#define XB_TOP      3328
#define XB_TOPGEN   3392
#define XCD_BAR_WORDS 3456
#define XB_SPIN_CAP (1u << 18)

__device__ __forceinline__ unsigned xb_ld(unsigned* p)              { return __hip_atomic_load(p, __ATOMIC_RELAXED, __HIP_MEMORY_SCOPE_AGENT); }
__device__ __forceinline__ unsigned xb_add(unsigned* p, unsigned v) { return __hip_atomic_fetch_add(p, v, __ATOMIC_RELAXED, __HIP_MEMORY_SCOPE_AGENT); }
__device__ __forceinline__ unsigned xb_xcc_id() { return (unsigned)__builtin_amdgcn_s_getreg((3 << 11) | 20) & 0xFu; }
#define XB_SPIN(cond, bar) do { unsigned _sp = 0; while (cond) { __builtin_amdgcn_s_sleep(1); \
    if ((++_sp & 255u) == 0u) { if (xb_ld(&(bar)[XB_TMO])) break; if (_sp > XB_SPIN_CAP) { atomicAdd(&(bar)[XB_TMO], 1u); break; } } } } while (0)

struct XcdBarrier {
    unsigned* bar; unsigned x;
    volatile LAS unsigned* st;
};

__device__ __forceinline__ XcdBarrier xcd_barrier_post(unsigned* bar, volatile LAS unsigned* st) {
    XcdBarrier b; b.bar = bar; b.x = xb_xcc_id(); b.st = st;
    if (threadIdx.x == 0) (void)xb_add(&bar[XB_XCNT(b.x)], 1u);
    return b;
}
__device__ __forceinline__ void xcd_barrier_complete(unsigned* bar, unsigned x, unsigned& nloc, unsigned& nx) {
    const unsigned G = gridDim.x * gridDim.y * gridDim.z;
    unsigned sum, cnt, mine, sp = 0u;
    for (;;) {
        sum = 0u; cnt = 0u; mine = 0u;
#pragma unroll
        for (unsigned j = 0; j < 16; ++j) { const unsigned c = xb_ld(&bar[XB_XCNT(j)]); sum += c; cnt += (c > 0u) ? 1u : 0u; mine = (j == x) ? c : mine; }
        if (sum == G) break;
        __builtin_amdgcn_s_sleep(1);
        if ((++sp & 255u) == 0u) { if (xb_ld(&bar[XB_TMO])) break; if (sp > XB_SPIN_CAP) { atomicAdd(&bar[XB_TMO], 1u); break; } }
    }
    nloc = mine > 0u ? mine : 1u; nx = cnt > 0u ? cnt : 1u;
}

__device__ __forceinline__ void xcd_barrier(const XcdBarrier& b) {
    asm volatile("s_waitcnt vmcnt(0)" ::: "memory");
    __syncthreads();
    if (threadIdx.x == 0) {
        unsigned* bar = b.bar;
        __builtin_amdgcn_s_waitcnt(0);
        unsigned nloc = b.st[0], nx = b.st[1];
        if (nloc == 0u) { xcd_barrier_complete(bar, b.x, nloc, nx); b.st[0] = nloc; b.st[1] = nx; }
        const unsigned old = xb_add(&bar[XB_XSUB(b.x)], 1u);
        const unsigned gen = old / nloc;
        if (old + 1u == (gen + 1u) * nloc) {
            __builtin_amdgcn_fence(__ATOMIC_RELEASE, "agent");
            asm volatile("s_waitcnt vmcnt(0)" ::: "memory");
            const unsigned og = xb_add(&bar[XB_TOP], 1u);
            const unsigned tg = og / nx;
            if (og + 1u == (tg + 1u) * nx) xb_add(&bar[XB_TOPGEN], 1u);
            else XB_SPIN(xb_ld(&bar[XB_TOPGEN]) == tg, bar);
            __builtin_amdgcn_fence(__ATOMIC_ACQUIRE, "agent");
            xb_add(&bar[XB_XGEN(b.x)], 1u);
            asm volatile("s_waitcnt vmcnt(0)" ::: "memory");
        } else {
            XB_SPIN(xb_ld(&bar[XB_XGEN(b.x)]) == gen, bar);
            __builtin_amdgcn_fence(__ATOMIC_ACQUIRE, "agent");
            asm volatile("s_waitcnt vmcnt(0)" ::: "memory");
        }
    }
    __syncthreads();
}

DI void transpose_item(const float* W, int ldw, int n0src, int k0, bf16_t* WT, int ldt, int nrow0, const float* kscale, LAS float* scr, int lane) {
    float v[32];
#pragma unroll
    for (int i = 0; i < 32; ++i) { const int kk = 2 * i + (lane >> 5); v[i] = n0src >= 0 ? __builtin_nontemporal_load(&W[(size_t)(k0 + kk) * ldw + n0src + (lane & 31)]) : 0.f;     }
    if (kscale) {
#pragma unroll
        for (int i = 0; i < 32; ++i) v[i] *= kscale[k0 + 2 * i + (lane >> 5)];
    }
#pragma unroll
    for (int i = 0; i < 32; ++i) scr[(2 * i + (lane >> 5)) * 33 + (lane & 31)] = v[i];
    LDSW();
    const int c = lane & 7;
#pragma unroll
    for (int j = 0; j < 4; ++j) { const int n = (lane >> 3) + 8 * j; const LAS float* s = scr + (8 * c) * 33 + n;
        u32x4 o; o.x = pk2(s[0 * 33], s[1 * 33]); o.y = pk2(s[2 * 33], s[3 * 33]); o.z = pk2(s[4 * 33], s[5 * 33]); o.w = pk2(s[6 * 33], s[7 * 33]);
        *(u32x4*)(WT + (size_t)(nrow0 + n) * ldt + k0 + 8 * c) = o; }
    LDSW();
}

DI void setup_transposes(const Params& P, LAS unsigned char* lds, int gw, int ngw, int wid, int lane) {
    LAS float* scr = (LAS float*)(lds + wid * 8704);
    unsigned char* ws = P.ws;
    constexpr int I_IN = 32 * 384, I_OUT = 32 * 64, I_BR = 8 * 64, I_UQ = 8 * 24, I_UKV = 4 * 32;
    constexpr int PER_LAYER = I_IN + I_OUT + 3 * I_BR + I_UQ + 2 * I_UKV;
    for (int it = gw; it < 2 * PER_LAYER; it += ngw) {
        const int l = it / PER_LAYER; int r = it - l * PER_LAYER;
        if (r < I_IN) {
            const int kb = r / 384, nb = r % 384, n0 = nb * 32;
            const int src = n0 < 2816 ? n0 : (n0 < 12032 ? n0 + 32 : (n0 < 12064 ? n0 - 12032 + 2816 : -1));
            transpose_item(P.in[I_WIN] + (size_t)l * DM * PROJ_ORIG, PROJ_ORIG, src, kb * 64, (bf16_t*)(ws + O_WIN) + (size_t)l * NPROJ * DM, DM, n0, nullptr, scr, lane); continue; }
        r -= I_IN;
        if (r < I_OUT) { const int kb = r / 64, nb = r % 64;
            transpose_item(P.in[I_WOUT] + (size_t)l * DM * DM, DM, nb * 32, kb * 64, (bf16_t*)(ws + O_WOUT) + (size_t)l * DM * DM, DM, nb * 32, nullptr, scr, lane); continue; }
        r -= I_OUT;
        if (r < 3 * I_BR) { const int br = r / I_BR, q = r % I_BR, kb = q / 64, nb = q % 64;
            transpose_item(P.in[I_WBNA + br] + (size_t)l * 512 * DM, DM, nb * 32, kb * 64, (bf16_t*)(ws + O_WBR) + (size_t)(l * 3 + br) * DM * 512, 512, nb * 32, nullptr, scr, lane); continue; }
        r -= 3 * I_BR;
        if (r < I_UQ) { const int kb = r / 24, nb = r % 24;
            transpose_item(P.in[I_WUQ] + (size_t)l * 512 * 768, 768, nb * 32, kb * 64, (bf16_t*)(ws + O_WUQ) + (size_t)l * 768 * 512, 512, nb * 32, P.in[I_GMQ] + l * 512, scr, lane); continue; }
        r -= I_UQ;
        { const int var = r / I_UKV, q = r % I_UKV, kb = q / 32, nb = q % 32;
            transpose_item(P.in[I_WUKV] + (size_t)l * 256 * 1024, 1024, nb * 32, kb * 64, (bf16_t*)(ws + (var ? O_WUKVG : O_WUKV)) + (size_t)l * 1024 * 256, 256, nb * 32,
                           var ? P.in[I_GMKV] + l * 256 : nullptr, scr, lane); }
    }
}

DI void win1_transposes(const Params& P, LAS unsigned char* lds, int gw, int ngw, int wid, int lane) {
    LAS float* scr = (LAS float*)(lds + wid * 8704);
    const float* W = P.in[I_WIN] + (size_t)DM * PROJ_ORIG; bf16_t* WT = (bf16_t*)(P.ws + O_WIN) + (size_t)NPROJ * DM;
#pragma unroll 1
    for (int r = gw; r < 32 * 384; r += ngw) {
        const int kb = r / 384, nb = r % 384, n0 = nb * 32;
        const int src = n0 < 2816 ? n0 : (n0 < 12032 ? n0 + 32 : (n0 < 12064 ? n0 - 12032 + 2816 : -1));
        transpose_item(W, PROJ_ORIG, src, kb * 64, WT, DM, n0, nullptr, scr, lane);
    }
}

DI void setup_gemv(const Params& P, LAS unsigned char* lds, int job, int tid, int wid, int lane) {
    const int l = job / 96, col0 = (job % 96) * 64;
    LAS float* sv = (LAS float*)(lds + GV_SV); LAS float* part = (LAS float*)(lds + GV_PART);
    for (int i = tid; i < 3 * 2048; i += 512) { const int vec = i >> 11, k = i & 2047; const float x = vec == 0 ? P.in[I_CCTX][k] : P.in[I_C][(vec - 1) * 2048 + k]; sv[i] = x / (1.f + expf(-x)); }
    __syncthreads();
    const int rg = lane >> 4, c4 = lane & 15;
    const float* W = P.in[I_WADA] + (size_t)l * DM * 6144 + col0 + 4 * c4;
    f32x4 a0 = {0.f, 0.f, 0.f, 0.f}, a1 = a0, a2 = a0;
#pragma unroll 8
    for (int it = 0; it < 64; ++it) { const int k = wid * 256 + 4 * it + rg; const f32x4 w = __builtin_nontemporal_load((const f32x4*)(W + (size_t)k * 6144)); a0 += w * sv[k]; a1 += w * sv[2048 + k]; a2 += w * sv[4096 + k]; }
#pragma unroll
    for (int e = 0; e < 4; ++e) {
        a0[e] += xor_swz<16>(a0[e]); a0[e] = sum_x32(a0[e]);
        a1[e] += xor_swz<16>(a1[e]); a1[e] = sum_x32(a1[e]);
        a2[e] += xor_swz<16>(a2[e]); a2[e] = sum_x32(a2[e]);
    }
    if (lane < 16) { *(LAS f32x4*)(part + (wid * 3 + 0) * 64 + 4 * c4) = a0; *(LAS f32x4*)(part + (wid * 3 + 1) * 64 + 4 * c4) = a1; *(LAS f32x4*)(part + (wid * 3 + 2) * 64 + 4 * c4) = a2; }
    __syncthreads();
    if (tid < 192) {
        const int vec = tid >> 6, c = tid & 63; float* MOD = (float*)(P.ws + O_MOD);
        float s = P.in[I_BADA][l * 6144 + col0 + c];
#pragma unroll
        for (int w = 0; w < 8; ++w) s += part[(w * 3 + vec) * 64 + c];
        MOD[(size_t)(l * 3 + vec) * 6144 + col0 + c] = s;
    }
    __syncthreads();
}

DI void setup_convert(const Params& P, int gtid, int ngt) {
    unsigned char* ws = P.ws;
    bf16_t* CKA = (bf16_t*)(ws + O_CKA); bf16_t* CVTA = (bf16_t*)(ws + O_CVTA); bf16_t* CCKV = (bf16_t*)(ws + O_CCKV); bf16_t* KRS = (bf16_t*)(ws + O_KRS); float* ROPE = (float*)(ws + O_ROPE);
    constexpr int NA = 1048576, NB = 1048576, NC = 524288, ND = 65536, NE = 512;
    for (int i = gtid; i < NA + NB + NC + ND + NE; i += ngt) {
        int x = i;
        if (x < NA) { const int c = x & 511, t = (x >> 9) & 511, b = (x >> 18) & 1, l = x >> 19; CKA[x] = f2bf(P.in[I_CNK][((size_t)(b * 2 + l) * 512 + t) * 512 + c]); continue; }
        x -= NA;
        if (x < NB) { const int t = x & 511, dv = (x >> 9) & 63, hd = (x >> 15) & 7, b = (x >> 18) & 1, l = x >> 19; CVTA[x] = f2bf(P.in[I_CNV][((size_t)(b * 2 + l) * 512 + t) * 512 + hd * 64 + dv]); continue; }
        x -= NB;
        if (x < NC) { const int c = x & 255, t = (x >> 8) & 511, b = (x >> 17) & 1, l = x >> 18; CCKV[x] = f2bf(P.in[I_CCKV][((size_t)(b * 2 + l) * 512 + t) * 256 + c]); continue; }
        x -= NC;
        if (x < ND) { const int d = x & 31, t = (x >> 5) & 511, b = (x >> 14) & 1, l = x >> 15; KRS[((size_t)(l * 2 + b) * 2560 + t) * 32 + d] = f2bf(P.in[I_CKR][((size_t)(b * 2 + l) * 512 + t) * 32 + d]); continue; }
        x -= ND;
        { const int fi = x & 7, pos = x >> 3; const float inv = powf(10000.f, -(float)fi / 8.f), ang = (float)pos * inv; ROPE[x * 2] = cosf(ang); ROPE[x * 2 + 1] = sinf(ang); }
    }
}

DI void prenorm_store(const f32x4 (&y)[8], float ss, const float* gpre, const float* mod, bf16_t* hrow, int lane) {
    const float rstd = rsqrtf(ss * (1.f / 2048.f) + EPS);
#pragma unroll
    for (int j = 0; j < 8; ++j) { const int c = 4 * lane + 256 * j;
        const f32x4 g = *(const f32x4*)(gpre + c), sh = *(const f32x4*)(mod + c), sc = *(const f32x4*)(mod + 2048 + c);
        const f32x4 hh = y[j] * rstd * g * (sc + 1.f) + sh;
        u32x2 w; w.x = pk2(hh[0], hh[1]); w.y = pk2(hh[2], hh[3]); *(u32x2*)(hrow + c) = w; }
}
DI void prenorm_layer0(const Params& P, int gw, int ngw, int lane) {
    const float* MOD = (const float*)(P.ws + O_MOD); bf16_t* H = (bf16_t*)(P.ws + O_H);
    for (int r = gw; r < NTOK; r += ngw) {
        const float* xr = r < NPR ? P.in[I_XP] + (size_t)r * DM : P.in[I_XS] + (size_t)(r - NPR) * DM; const int vec = r < NPR ? 0 : 1 + ((r - NPR) >> 11);
        f32x4 y[8]; float ss = 0.f;
#pragma unroll
        for (int j = 0; j < 8; ++j) { y[j] = __builtin_nontemporal_load((const f32x4*)(xr + 4 * lane + 256 * j)); ss += (y[j][0] * y[j][0] + y[j][1] * y[j][1]) + (y[j][2] * y[j][2] + y[j][3] * y[j][3]); }
        ss = wave_sum(ss);
        prenorm_store(y, ss, P.in[I_GPRE], MOD + (size_t)vec * 6144, H + (size_t)r * DM, lane);
    }
}
DI void postnorm_phase(const Params& P, int layer, int gw, int ngw, int lane) {
    OPAQUE_V(lane);
    const float* MOD = (const float*)(P.ws + O_MOD); bf16_t* H = (bf16_t*)(P.ws + O_H); const bf16_t* OB = (const bf16_t*)(P.ws + O_OUTB); const float* OSS = (const float*)(P.ws + O_OSS);
    for (int r = gw; r < NTOK; r += ngw) {
        const int vec = r < NPR ? 0 : 1 + ((r - NPR) >> 11);
        float* yr = r < NPR ? P.out + OUT_YP + (size_t)r * DM : P.out + OUT_YS + (size_t)(r - NPR) * DM;
        const float* xr = layer == 0 ? (r < NPR ? P.in[I_XP] + (size_t)r * DM : P.in[I_XS] + (size_t)(r - NPR) * DM) : yr;
        float so = lane < 32 ? OSS[(size_t)r * 32 + lane] : 0.f; so = wave_sum(so);
        const float rstd = rsqrtf(so * (1.f / 2048.f) + EPS);
        const float* mod = MOD + (size_t)(layer * 3 + vec) * 6144; const float* gp = P.in[I_GPOST] + layer * DM;
        f32x4 y[8]; float ss = 0.f;
#pragma unroll
        for (int j = 0; j < 8; ++j) { const int c = 4 * lane + 256 * j;
            const f32x4 x = __builtin_nontemporal_load((const f32x4*)(xr + c)), gt = *(const f32x4*)(mod + 4096 + c), g = *(const f32x4*)(gp + c); const u32x2 ob = *(const u32x2*)(OB + (size_t)r * DM + c);
            const f32x4 o = {bflo(ob.x), bfhi(ob.x), bflo(ob.y), bfhi(ob.y)};
            y[j] = x + gt * (o * rstd * g); ss += (y[j][0] * y[j][0] + y[j][1] * y[j][1]) + (y[j][2] * y[j][2] + y[j][3] * y[j][3]); }
#pragma unroll
        for (int j = 0; j < 8; ++j) __builtin_nontemporal_store(y[j], (f32x4*)(yr + 4 * lane + 256 * j));
        if (layer == 0) { ss = wave_sum(ss); prenorm_store(y, ss, P.in[I_GPRE] + DM, MOD + (size_t)(3 + vec) * 6144, H + (size_t)r * DM, lane); }
    }
}

DI void mla_finish(const Params& P, int layer, int gtid, int ngt) {
    unsigned char* ws = P.ws; OPAQUE_V(gtid); OPAQUE_S(ws);
    const float* CKVF = (const float*)(ws + O_CKVF); const float* CKVSS = (const float*)(ws + O_CKVSS); const float* KRF = (const float*)(ws + O_KRF); const float* ROPE = (const float*)(ws + O_ROPE);
    bf16_t* KRP = (bf16_t*)(ws + O_KRP); bf16_t* KRS = (bf16_t*)(ws + O_KRS);
#pragma unroll 4
    for (int i = gtid; i < NPR * 256; i += ngt) { const int r = i >> 8, c = i & 255; const f32x4 sa = *(const f32x4*)(CKVSS + (size_t)r * 4);
        const float rs = rsqrtf(((sa[0] + sa[1]) + (sa[2] + sa[3])) * (1.f / 256.f) + EPS);
        P.out[OUT_CKV + ((size_t)((r >> 8) * 2 + layer) * 256 + (r & 255)) * 256 + c] = CKVF[i] * rs * P.in[I_GMKV][layer * 256 + c]; }
#pragma unroll 3
    for (int i = gtid; i < NTOK * 32; i += ngt) { const int r = i >> 5, d = i & 31; const float x = KRF[i];
        if (r < NPR) { P.out[OUT_KR + ((size_t)((r >> 8) * 2 + layer) * 256 + (r & 255)) * 32 + d] = x; KRP[i] = f2bf(x); }
        else { const int rs_ = r - NPR, bs = rs_ >> 11, ts = rs_ & 2047; const int pos = (d >> 4) ? (ts & 63) : (ts >> 6); const float cs = ROPE[(pos * 8 + (d & 7)) * 2], sn = ROPE[(pos * 8 + (d & 7)) * 2 + 1];
            const float pr = KRF[i ^ 8]; const float y = x * cs + ((d & 8) ? pr : -pr) * sn;
            KRS[((size_t)(layer * 2 + bs) * 2560 + 512 + ts) * 32 + d] = f2bf(y); }
    }
}

DI int crow16(int i, int h) { return (i & 3) + 8 * (i >> 2) + 4 * h; }
DI s16x4 ld8(const LAS unsigned char* p) { return *(const LAS s16x4*)p; }
DI s16x4 ld8(const unsigned char* p) { return *(const s16x4*)p; }
template <class VP>
DI void softmax_pv(f32x16& s, float& mrun, float& lrun, f32x16& o0, f32x16& o1, VP vbase, int vstride, int r, int h) {
    float mx = s[0];
#pragma unroll
    for (int i = 1; i < 16; ++i) mx = fmaxf(mx, s[i]);
    mx = max_x32(mx);
    const float mnew = fmaxf(mrun, mx), alpha = __builtin_amdgcn_exp2f(mrun - mnew);
    float rs = 0.f;
#pragma unroll
    for (int i = 0; i < 16; ++i) { s[i] = __builtin_amdgcn_exp2f(s[i] - mnew); rs += s[i]; }
    rs = sum_x32(rs);
    lrun = lrun * alpha + rs; mrun = mnew;
    o0 *= alpha; o1 *= alpha;
#pragma unroll
    for (int s2 = 0; s2 < 2; ++s2) {
        u32x4 pw; pw.x = pk2(s[8 * s2 + 0], s[8 * s2 + 1]); pw.y = pk2(s[8 * s2 + 2], s[8 * s2 + 3]); pw.z = pk2(s[8 * s2 + 4], s[8 * s2 + 5]); pw.w = pk2(s[8 * s2 + 6], s[8 * s2 + 7]);
        const bf16x8 pb = __builtin_bit_cast(bf16x8, pw);
        {   VP p = vbase + (size_t)r * vstride + (16 * s2 + 4 * h) * 2;
            const s16x4 lo = ld8(p), hi = ld8(p + 16); const bf16x8 va = __builtin_shufflevector(lo, hi, 0, 1, 2, 3, 4, 5, 6, 7);
            o0 = MFMA32(va, pb, o0); }
        {   VP p = vbase + (size_t)(r + 32) * vstride + (16 * s2 + 4 * h) * 2;
            const s16x4 lo = ld8(p), hi = ld8(p + 16); const bf16x8 va = __builtin_shufflevector(lo, hi, 0, 1, 2, 3, 4, 5, 6, 7);
            o1 = MFMA32(va, pb, o1); }
    }
}

template <class VP>
DI void softmax_pv2(f32x16& sa, f32x16& sb, float& mrun, float& lrun, f32x16& o0, f32x16& o1, VP vbase, int vstride, int r, int h) {
    float mx = fmaxf(sa[0], sb[0]);
#pragma unroll
    for (int i = 1; i < 16; ++i) mx = fmaxf(mx, fmaxf(sa[i], sb[i]));
    mx = max_x32(mx);
    const float mnew = fmaxf(mrun, mx), alpha = __builtin_amdgcn_exp2f(mrun - mnew);
    float rs = 0.f;
#pragma unroll
    for (int i = 0; i < 16; ++i) { sa[i] = __builtin_amdgcn_exp2f(sa[i] - mnew); sb[i] = __builtin_amdgcn_exp2f(sb[i] - mnew); rs += sa[i] + sb[i]; }
    rs = sum_x32(rs);
    lrun = lrun * alpha + rs; mrun = mnew;
    o0 *= alpha; o1 *= alpha;
#pragma unroll
    for (int sub = 0; sub < 2; ++sub) {
        const f32x16& s = sub ? sb : sa;
#pragma unroll
        for (int s2 = 0; s2 < 2; ++s2) {
            u32x4 pw; pw.x = pk2(s[8 * s2 + 0], s[8 * s2 + 1]); pw.y = pk2(s[8 * s2 + 2], s[8 * s2 + 3]); pw.z = pk2(s[8 * s2 + 4], s[8 * s2 + 5]); pw.w = pk2(s[8 * s2 + 6], s[8 * s2 + 7]);
            const bf16x8 pb = __builtin_bit_cast(bf16x8, pw);
            {   VP p = vbase + (size_t)r * vstride + (32 * sub + 16 * s2 + 4 * h) * 2;
                const s16x4 lo = ld8(p), hi = ld8(p + 16); o0 = MFMA32(__builtin_shufflevector(lo, hi, 0, 1, 2, 3, 4, 5, 6, 7), pb, o0); }
            {   VP p = vbase + (size_t)(r + 32) * vstride + (32 * sub + 16 * s2 + 4 * h) * 2;
                const s16x4 lo = ld8(p), hi = ld8(p + 16); o1 = MFMA32(__builtin_shufflevector(lo, hi, 0, 1, 2, 3, 4, 5, 6, 7), pb, o1); }
        }
    }
}

DI void softmax_pv_regs(f32x16& s, float& mrun, float& lrun, f32x16& o0, f32x16& o1, const bf16x8 (&va)[2][2]) {
    float mx = s[0];
#pragma unroll
    for (int i = 1; i < 16; ++i) mx = fmaxf(mx, s[i]);
    mx = max_x32(mx);
    const float mnew = fmaxf(mrun, mx), alpha = __builtin_amdgcn_exp2f(mrun - mnew);
    float rs = 0.f;
#pragma unroll
    for (int i = 0; i < 16; ++i) { s[i] = __builtin_amdgcn_exp2f(s[i] - mnew); rs += s[i]; }
    rs = sum_x32(rs);
    lrun = lrun * alpha + rs; mrun = mnew;
    o0 *= alpha; o1 *= alpha;
#pragma unroll
    for (int s2 = 0; s2 < 2; ++s2) {
        u32x4 pw; pw.x = pk2(s[8 * s2 + 0], s[8 * s2 + 1]); pw.y = pk2(s[8 * s2 + 2], s[8 * s2 + 3]); pw.z = pk2(s[8 * s2 + 4], s[8 * s2 + 5]); pw.w = pk2(s[8 * s2 + 6], s[8 * s2 + 7]);
        const bf16x8 pb = __builtin_bit_cast(bf16x8, pw);
        o0 = MFMA32(va[s2][0], pb, o0); o1 = MFMA32(va[s2][1], pb, o1);
    }
}

struct AttnSeg { const bf16_t* K1; const bf16_t* K2; const bf16_t* VT; int vts; int nk; };

template <int NST, bool SPLIT, bool LOCAL>
DI void attn_unit(LAS unsigned char* lds, const bf16_t* Q, int qstride, const AttnSeg sa, const AttnSeg sb, const bf16_t* gate, bf16_t* outp,
                  const bf16_t* Kloc, const bf16_t* VTloc, const float* rpbh, int grow0, const int wid_in) {
    const int wid = wid_in, lane = lane_id(), tid = wid * 64 + lane, r = lane & 31, h = lane >> 5;
    const int qi = SPLIT ? (wid & 3) : wid, grp = SPLIT ? (wid >> 2) : 0;
    const int qrow = qi * 32 + r;
    bf16x8 qf[NST];
#pragma unroll
    for (int st = 0; st < NST; ++st) qf[st] = *(const bf16x8*)(Q + (size_t)qrow * qstride + 16 * st + 8 * h);
    f32x16 o0, o1;
#pragma unroll
    for (int i = 0; i < 16; ++i) { o0[i] = 0.f; o1[i] = 0.f; }
    float mrun = NEG, lrun = 0.f;
    if constexpr (LOCAL) {
        const int gr = grow0 + (qi >> 1), qc = 32 * (qi & 1) + r;
        const int kr0 = min(max(gr - 4, 0), 24), win0 = min(max(qc - 8, 0), 48);
        bf16x8 kfA[NST], kfB[NST], vaA[2][2], vaB[2][2]; float bsA[16], bsB[16];
#define LOC_LOAD(KF, VA, BS, lt) do { const int krow_ = kr0 + 4 * grp + ((lt) >> 1), c0_ = 32 * ((lt) & 1); \
            _Pragma("unroll") for (int st = 0; st < NST; ++st) KF[st] = *(const bf16x8*)(Kloc + (size_t)(krow_ * 64 + c0_ + r) * 512 + 16 * st + 8 * h); \
            _Pragma("unroll") for (int s2 = 0; s2 < 2; ++s2) _Pragma("unroll") for (int blk = 0; blk < 2; ++blk) { \
                const unsigned char* p_ = (const unsigned char*)(VTloc + krow_ * 64 + c0_) + (size_t)(r + 32 * blk) * 4096 + (16 * s2 + 4 * h) * 2; \
                const s16x4 lo_ = ld8(p_), hi_ = ld8(p_ + 16); VA[s2][blk] = __builtin_shufflevector(lo_, hi_, 0, 1, 2, 3, 4, 5, 6, 7); } \
            const float* rp_ = rpbh + (krow_ - gr + 7) * 31; \
            _Pragma("unroll") for (int i = 0; i < 16; ++i) { const int kc_ = c0_ + crow16(i, h); BS[i] = rp_[min(max(kc_ - qc + 15, 0), 30)]; } } while (0)
#define LOC_COMP(KF, VA, BS, lt) do { const int c0_ = 32 * ((lt) & 1); f32x16 s_; \
            _Pragma("unroll") for (int i = 0; i < 16; ++i) s_[i] = 0.f; \
            _Pragma("unroll") for (int st = 0; st < NST; ++st) s_ = MFMA32(KF[st], qf[st], s_); \
            _Pragma("unroll") for (int i = 0; i < 16; ++i) { const int kc_ = c0_ + crow16(i, h); const bool ok_ = (kc_ >= win0) && (kc_ < win0 + 16); s_[i] = ok_ ? s_[i] + BS[i] * LOG2E : NEG; } \
            softmax_pv_regs(s_, mrun, lrun, o0, o1, VA); } while (0)
        LOC_LOAD(kfA, vaA, bsA, 0);
#pragma unroll
        for (int lt = 0; lt < 8; lt += 2) {
            LOC_LOAD(kfB, vaB, bsB, lt + 1);
            LOC_COMP(kfA, vaA, bsA, lt);
            if (lt + 2 < 8) LOC_LOAD(kfA, vaA, bsA, lt + 2);
            LOC_COMP(kfB, vaB, bsB, lt + 1);
        }
#undef LOC_LOAD
#undef LOC_COMP
    }
    constexpr int TK = SPLIT ? 128 : 64, LTK = SPLIT ? 7 : 6;
    constexpr int VST = SPLIT ? 272 : VSTR;
    constexpr int AK1 = TK * KSTR, AV0 = 2 * TK * KSTR, AV1 = AV0 + 64 * VST, AMRG = AV0 + 2 * 64 * VST;
    static_assert(AMRG + 4 * 34 * 64 * 4 <= LDS_BAR, "attention LDS map");
    const int nta = sa.nk >> LTK, nt = nta + (sb.nk >> LTK);
    u32x4 rk1[SPLIT ? 2 : 1], rk2 = {0u, 0u, 0u, 0u}, rv[SPLIT ? 2 : 1];
#define ATT_LOAD(t) do { const bool ina = (t) < nta; const int key0 = ((t) - (ina ? 0 : nta)) * TK; \
        const bf16_t* k1_ = ina ? sa.K1 : sb.K1; const bf16_t* k2_ = ina ? sa.K2 : sb.K2; const bf16_t* vt_ = ina ? sa.VT : sb.VT; const int vts_ = ina ? sa.vts : sb.vts; \
        _Pragma("unroll") for (int q_ = 0; q_ < (SPLIT ? 2 : 1); ++q_) { \
            rk1[q_] = *(const u32x4*)(k1_ + (size_t)(key0 + 64 * q_ + (tid >> 3)) * 512 + (tid & 7) * 8); \
            rv[q_] = *(const u32x4*)(vt_ + (size_t)(tid >> 3) * vts_ + key0 + 64 * q_ + (tid & 7) * 8); } \
        if (NST == 6 && (SPLIT || tid < 256)) rk2 = *(const u32x4*)(k2_ + (size_t)(key0 + (tid >> 2)) * 32 + (tid & 3) * 8); } while (0)
#define ATT_STORE(b) do { const int kb_ = (b) ? AK1 : 0, vb_ = (b) ? AV1 : AV0; \
        _Pragma("unroll") for (int q_ = 0; q_ < (SPLIT ? 2 : 1); ++q_) { \
            *(LAS u32x4*)(lds + kb_ + (64 * q_ + (tid >> 3)) * KSTR + (tid & 7) * 16) = rk1[q_]; \
            *(LAS u32x4*)(lds + vb_ + (tid >> 3) * VST + 128 * q_ + (tid & 7) * 16) = rv[q_]; } \
        if (NST == 6 && (SPLIT || tid < 256)) *(LAS u32x4*)(lds + kb_ + (tid >> 2) * KSTR + 128 + (tid & 3) * 16) = rk2; } while (0)
    ATT_LOAD(0); ATT_STORE(0);
    __syncthreads();
#pragma unroll 1
    for (int t = 0; t < nt; ++t) {
        if (t + 1 < nt) ATT_LOAD(t + 1);
        const int kb = ((t & 1) ? AK1 : 0) + (SPLIT ? grp * 64 * KSTR : 0), vb = ((t & 1) ? AV1 : AV0) + (SPLIT ? grp * 128 : 0);
        {   f32x16 s0, s1;
#pragma unroll
            for (int i = 0; i < 16; ++i) { s0[i] = 0.f; s1[i] = 0.f; }
#pragma unroll
            for (int st = 0; st < NST; ++st) {
                const bf16x8 kf0 = *(const LAS bf16x8*)(lds + kb + r * KSTR + (16 * st + 8 * h) * 2), kf1 = *(const LAS bf16x8*)(lds + kb + (32 + r) * KSTR + (16 * st + 8 * h) * 2);
                s0 = MFMA32(kf0, qf[st], s0); s1 = MFMA32(kf1, qf[st], s1); }
            softmax_pv2(s0, s1, mrun, lrun, o0, o1, (const LAS unsigned char*)(lds + vb), VST, r, h);
        }
        if (t + 1 < nt) ATT_STORE((t + 1) & 1);
        __syncthreads();
    }
#undef ATT_LOAD
#undef ATT_STORE
    if constexpr (SPLIT) {
        LAS float* mg = (LAS float*)(lds + AMRG) + qi * 34 * 64;
        if (grp == 1) {
#pragma unroll
            for (int k = 0; k < 16; ++k) { mg[k * 64 + lane] = o0[k]; mg[(16 + k) * 64 + lane] = o1[k]; }
            mg[32 * 64 + lane] = mrun; mg[33 * 64 + lane] = lrun;
        }
        __syncthreads();
        if (grp == 0) {
            const float m2 = mg[32 * 64 + lane], l2 = mg[33 * 64 + lane], mn = fmaxf(mrun, m2), a1 = __builtin_amdgcn_exp2f(mrun - mn), a2 = __builtin_amdgcn_exp2f(m2 - mn);
            lrun = lrun * a1 + l2 * a2;
#pragma unroll
            for (int k = 0; k < 16; ++k) { o0[k] = o0[k] * a1 + mg[k * 64 + lane] * a2; o1[k] = o1[k] * a1 + mg[(16 + k) * 64 + lane] * a2; }
        }
    }
    if (!SPLIT || grp == 0) {
        const float inv = 1.f / lrun;
#pragma unroll
        for (int g4 = 0; g4 < 4; ++g4) {
            { const int dv0 = 8 * g4 + 4 * h; const u32x2 gt = *(const u32x2*)(gate + (size_t)qrow * 512 + dv0);
              u32x2 w; w.x = pk2(o0[4 * g4] * inv * bflo(gt.x), o0[4 * g4 + 1] * inv * bfhi(gt.x)); w.y = pk2(o0[4 * g4 + 2] * inv * bflo(gt.y), o0[4 * g4 + 3] * inv * bfhi(gt.y));
              *(u32x2*)(outp + (size_t)qrow * 512 + dv0) = w; }
            { const int dv0 = 32 + 8 * g4 + 4 * h; const u32x2 gt = *(const u32x2*)(gate + (size_t)qrow * 512 + dv0);
              u32x2 w; w.x = pk2(o1[4 * g4] * inv * bflo(gt.x), o1[4 * g4 + 1] * inv * bfhi(gt.x)); w.y = pk2(o1[4 * g4 + 2] * inv * bflo(gt.y), o1[4 * g4 + 3] * inv * bfhi(gt.y));
              *(u32x2*)(outp + (size_t)qrow * 512 + dv0) = w; }
        }
    }
    if constexpr (SPLIT) __syncthreads();
}

constexpr int HM_WAVE = 20480, HM_Q = 0, HM_K = 4608, HM_KT = 9216, HM_VT = 14336, HM_ER = 19456, HM_EB = 19712;
static_assert(6 * HM_WAVE <= LDS_BYTES, "hgrn LDS map");
DI bf16x8 pack8(float a0, float a1, float a2, float a3, float a4, float a5, float a6, float a7) { u32x4 w; w.x = pk2(a0, a1); w.y = pk2(a2, a3); w.z = pk2(a4, a5); w.w = pk2(a6, a7); return __builtin_bit_cast(bf16x8, w); }
DI void hgrn_pass1(unsigned char* ws, LAS unsigned char* lds, int job, int slot, int lane) {
    OPAQUE_V(lane); OPAQUE_S(ws);
    const int dir = job & 1, head = (job >> 1) & 7, gs = job >> 4;
    int tok0; if (gs < 64) tok0 = (gs >> 1) * 256 + (gs & 1) * 128; else { const int x = gs - 64; tok0 = NPR + (x >> 4) * 2048 + (x & 15) * 128; }
    const float* LF = (const float*)(ws + (dir ? O_LFB : O_LFF)); const float* HQ = (const float*)(ws + O_HQ); const float* HV = (const float*)(ws + O_HV);
    float* OP = (float*)(ws + O_OPART) + (size_t)dir * NTOK * 512; bf16_t* QE = (bf16_t*)(ws + O_QE) + (size_t)dir * NTOK * 512;
    LAS unsigned char* L = lds + slot * HM_WAVE;
    const int r31 = lane & 31, h = lane >> 5, hc = head * 64 + lane, dt = dir ? -1 : 1;
    f32x16 S[2][2];
#pragma unroll
    for (int a = 0; a < 2; ++a)
#pragma unroll
        for (int b = 0; b < 2; ++b)
#pragma unroll
            for (int i = 0; i < 16; ++i) S[a][b][i] = 0.f;
    float Bgrp = 0.f;
#pragma unroll 1
    for (int ch = 0; ch < 4; ++ch) {
        const int tbase = dir ? tok0 + 127 - 32 * ch : tok0 + 32 * ch;
        {
            {   float vv[32];
#pragma unroll
                for (int t = 0; t < 32; ++t) vv[t] = HV[(size_t)(tbase + dt * t) * 512 + hc];
#pragma unroll
                for (int q4 = 0; q4 < 4; ++q4)
                    *(LAS bf16x8*)(L + HM_VT + lane * 80 + q4 * 16) = pack8(vv[8 * q4], vv[8 * q4 + 1], vv[8 * q4 + 2], vv[8 * q4 + 3], vv[8 * q4 + 4], vv[8 * q4 + 5], vv[8 * q4 + 6], vv[8 * q4 + 7]);
            }
            asm volatile("" ::: "memory");
            float lf[32], qv[32];
#pragma unroll
            for (int t = 0; t < 32; ++t) { const size_t o = (size_t)(tbase + dt * t) * 512 + hc; lf[t] = LF[o]; qv[t] = HQ[o]; }
#pragma unroll
            for (int t = 1; t < 32; ++t) lf[t] += lf[t - 1];
            const float bend = lf[31], r = 0.5f * bend, eg = __expf(Bgrp + r);
            float ekp = __expf(r);
#pragma unroll
            for (int q4 = 0; q4 < 4; ++q4) {
                float kt[8];
#pragma unroll
                for (int u = 0; u < 8; ++u) { const int t = 8 * q4 + u;
                    const float eq = __expf(lf[t] - r), ek = __expf(r - lf[t]);
                    const float f = eq * ekp; ekp = ek;
                    const float qt = qv[t] * eq; kt[u] = (1.f - f) * ek;
                    QE[(size_t)(tbase + dt * t) * 512 + hc] = f2bf(qt * eg);
                    *(LAS bf16_t*)(L + HM_Q + t * 144 + lane * 2) = f2bf(qt);
                    *(LAS bf16_t*)(L + HM_K + t * 144 + lane * 2) = f2bf(kt[u]); }
                *(LAS bf16x8*)(L + HM_KT + lane * 80 + q4 * 16) = pack8(kt[0], kt[1], kt[2], kt[3], kt[4], kt[5], kt[6], kt[7]);
            }
            *(LAS float*)(L + HM_ER + lane * 4) = __expf(r); *(LAS float*)(L + HM_EB + lane * 4) = __expf(bend);
            Bgrp += bend;
        }
        LDSW();
        f32x16 X;
#pragma unroll
        for (int i = 0; i < 16; ++i) X[i] = 0.f;
#pragma unroll
        for (int st = 0; st < 4; ++st) { const bf16x8 a = *(const LAS bf16x8*)(L + HM_K + r31 * 144 + (16 * st + 8 * h) * 2), bq = *(const LAS bf16x8*)(L + HM_Q + r31 * 144 + (16 * st + 8 * h) * 2); X = MFMA32(a, bq, X); }
#pragma unroll
        for (int i = 0; i < 16; ++i) X[i] = (crow16(i, h) > r31) ? 0.f : X[i];
        f32x16 O0, O1;
#pragma unroll
        for (int i = 0; i < 16; ++i) { O0[i] = 0.f; O1[i] = 0.f; }
#pragma unroll
        for (int s2 = 0; s2 < 2; ++s2) {
            const bf16x8 pb = pack8(X[8 * s2], X[8 * s2 + 1], X[8 * s2 + 2], X[8 * s2 + 3], X[8 * s2 + 4], X[8 * s2 + 5], X[8 * s2 + 6], X[8 * s2 + 7]);
            { const LAS unsigned char* p = L + HM_VT + r31 * 80 + (16 * s2 + 4 * h) * 2; const s16x4 lo = ld8(p), hi = ld8(p + 16); O0 = MFMA32(__builtin_shufflevector(lo, hi, 0, 1, 2, 3, 4, 5, 6, 7), pb, O0); }
            { const LAS unsigned char* p = L + HM_VT + (32 + r31) * 80 + (16 * s2 + 4 * h) * 2; const s16x4 lo = ld8(p), hi = ld8(p + 16); O1 = MFMA32(__builtin_shufflevector(lo, hi, 0, 1, 2, 3, 4, 5, 6, 7), pb, O1); }
        }
#pragma unroll
        for (int kb = 0; kb < 2; ++kb)
#pragma unroll
            for (int s2 = 0; s2 < 2; ++s2) {
                const LAS unsigned char* qp = L + HM_Q + r31 * 144 + (32 * kb + 16 * s2 + 4 * h) * 2; const s16x4 lo = ld8(qp), hi = ld8(qp + 16);
                const bf16x8 bqp = __builtin_shufflevector(lo, hi, 0, 1, 2, 3, 4, 5, 6, 7);
                const f32x4 e0 = *(const LAS f32x4*)(L + HM_ER + (32 * kb + 16 * s2 + 4 * h) * 4), e1 = *(const LAS f32x4*)(L + HM_ER + (32 * kb + 16 * s2 + 8 + 4 * h) * 4);
                { const f32x16& Sb = S[kb][0]; const bf16x8 a = pack8(Sb[8 * s2] * e0[0], Sb[8 * s2 + 1] * e0[1], Sb[8 * s2 + 2] * e0[2], Sb[8 * s2 + 3] * e0[3], Sb[8 * s2 + 4] * e1[0], Sb[8 * s2 + 5] * e1[1], Sb[8 * s2 + 6] * e1[2], Sb[8 * s2 + 7] * e1[3]);
                  O0 = MFMA32(a, bqp, O0); }
                { const f32x16& Sb = S[kb][1]; const bf16x8 a = pack8(Sb[8 * s2] * e0[0], Sb[8 * s2 + 1] * e0[1], Sb[8 * s2 + 2] * e0[2], Sb[8 * s2 + 3] * e0[3], Sb[8 * s2 + 4] * e1[0], Sb[8 * s2 + 5] * e1[1], Sb[8 * s2 + 6] * e1[2], Sb[8 * s2 + 7] * e1[3]);
                  O1 = MFMA32(a, bqp, O1); }
            }
        {   float* op = OP + (size_t)(tbase + dt * r31) * 512 + head * 64 + 4 * h;
#pragma unroll
            for (int g4 = 0; g4 < 4; ++g4) { *(f32x4*)(op + 8 * g4) = (f32x4){O0[4 * g4], O0[4 * g4 + 1], O0[4 * g4 + 2], O0[4 * g4 + 3]}; *(f32x4*)(op + 32 + 8 * g4) = (f32x4){O1[4 * g4], O1[4 * g4 + 1], O1[4 * g4 + 2], O1[4 * g4 + 3]}; }
        }
#pragma unroll
        for (int kb = 0; kb < 2; ++kb) {
            f32x4 er[4], eb[4];
#pragma unroll
            for (int g4 = 0; g4 < 4; ++g4) { er[g4] = *(const LAS f32x4*)(L + HM_ER + (32 * kb + 8 * g4 + 4 * h) * 4); eb[g4] = *(const LAS f32x4*)(L + HM_EB + (32 * kb + 8 * g4 + 4 * h) * 4); }
#pragma unroll
            for (int vb = 0; vb < 2; ++vb) {
                f32x16 T;
#pragma unroll
                for (int i = 0; i < 16; ++i) T[i] = 0.f;
#pragma unroll
                for (int st = 0; st < 2; ++st) { const bf16x8 a = *(const LAS bf16x8*)(L + HM_KT + (32 * kb + r31) * 80 + (16 * st + 8 * h) * 2), bv = *(const LAS bf16x8*)(L + HM_VT + (32 * vb + r31) * 80 + (16 * st + 8 * h) * 2); T = MFMA32(a, bv, T); }
#pragma unroll
                for (int i = 0; i < 16; ++i) S[kb][vb][i] = eb[i >> 2][i & 3] * S[kb][vb][i] + er[i >> 2][i & 3] * T[i];
            }
        }
        LDSW();
    }
    float* SG = (float*)(ws + O_SGRP) + (size_t)job * 4096;
#pragma unroll
    for (int kb = 0; kb < 2; ++kb)
#pragma unroll
        for (int vb = 0; vb < 2; ++vb)
#pragma unroll
            for (int i = 0; i < 16; ++i) SG[((kb * 2 + vb) * 16 + i) * 64 + lane] = S[kb][vb][i];
    ((float*)(ws + O_DGRP))[job * 64 + lane] = Bgrp;
}
DI void hgrn_pass2(const Params& P, int layer, int job, int lane) {
    unsigned char* ws = P.ws; OPAQUE_V(lane); OPAQUE_S(ws);
    const int c = job & 3, head = (job >> 2) & 7, gs = job >> 5;
    int b, g, ng, gsbase, tokg0; bool prompt;
    if (gs < 64) { prompt = true; b = gs >> 1; g = gs & 1; ng = 2; gsbase = gs & ~1; tokg0 = b * 256 + g * 128; }
    else { const int x = gs - 64; prompt = false; b = x >> 4; g = x & 15; ng = 16; gsbase = 64 + (x & ~15); tokg0 = NPR + b * 2048 + g * 128; }
    const int r31 = lane & 31, h = lane >> 5, t = tokg0 + 32 * c + r31;
    const float* SGRP = (const float*)(ws + O_SGRP);
    f32x16 O0, O1;
#pragma unroll
    for (int i = 0; i < 16; ++i) { O0[i] = 0.f; O1[i] = 0.f; }
#pragma unroll 1
    for (int dir = 0; dir < 2; ++dir) {
        const int gp = dir ? ng - 1 - g : g;
        if (prompt && gp == 0) continue;
        const int jq = ((gsbase + g) * 8 + head) * 2 + dir;
        const float* src = prompt ? SGRP + (size_t)(((gsbase + (g ^ 1)) * 8 + head) * 2 + dir) * 4096 : (const float*)(ws + O_GST) + (size_t)(jq - 1024) * 4096;
        f32x16 Gs[2][2];
#pragma unroll
        for (int kb = 0; kb < 2; ++kb)
#pragma unroll
            for (int vb = 0; vb < 2; ++vb)
#pragma unroll
                for (int i = 0; i < 16; ++i) Gs[kb][vb][i] = src[((kb * 2 + vb) * 16 + i) * 64 + lane];
        const bf16_t* qe = (const bf16_t*)(ws + O_QE) + (size_t)dir * NTOK * 512 + (size_t)t * 512 + head * 64;
#pragma unroll
        for (int kb = 0; kb < 2; ++kb)
#pragma unroll
            for (int s2 = 0; s2 < 2; ++s2) {
                const s16x4 lo = *(const s16x4*)(qe + 32 * kb + 16 * s2 + 4 * h), hi = *(const s16x4*)(qe + 32 * kb + 16 * s2 + 8 + 4 * h);
                const bf16x8 bqp = __builtin_shufflevector(lo, hi, 0, 1, 2, 3, 4, 5, 6, 7);
                { const f32x16& Sb = Gs[kb][0]; O0 = MFMA32(pack8(Sb[8 * s2], Sb[8 * s2 + 1], Sb[8 * s2 + 2], Sb[8 * s2 + 3], Sb[8 * s2 + 4], Sb[8 * s2 + 5], Sb[8 * s2 + 6], Sb[8 * s2 + 7]), bqp, O0); }
                { const f32x16& Sb = Gs[kb][1]; O1 = MFMA32(pack8(Sb[8 * s2], Sb[8 * s2 + 1], Sb[8 * s2 + 2], Sb[8 * s2 + 3], Sb[8 * s2 + 4], Sb[8 * s2 + 5], Sb[8 * s2 + 6], Sb[8 * s2 + 7]), bqp, O1); }
            }
    }
    const size_t ob = (size_t)t * 512 + head * 64 + 4 * h;
    const float* OP0 = (const float*)(ws + O_OPART) + ob; const float* OP1 = OP0 + (size_t)NTOK * 512;
    f32x4 tot[8]; float ss = 0.f;
#pragma unroll
    for (int g4 = 0; g4 < 4; ++g4) {
        tot[g4] = (f32x4){O0[4 * g4], O0[4 * g4 + 1], O0[4 * g4 + 2], O0[4 * g4 + 3]} + *(const f32x4*)(OP0 + 8 * g4) + *(const f32x4*)(OP1 + 8 * g4);
        tot[4 + g4] = (f32x4){O1[4 * g4], O1[4 * g4 + 1], O1[4 * g4 + 2], O1[4 * g4 + 3]} + *(const f32x4*)(OP0 + 32 + 8 * g4) + *(const f32x4*)(OP1 + 32 + 8 * g4);
    }
#pragma unroll
    for (int q = 0; q < 8; ++q) ss += (tot[q][0] * tot[q][0] + tot[q][1] * tot[q][1]) + (tot[q][2] * tot[q][2] + tot[q][3] * tot[q][3]);
    ss = sum_x32(ss);
    const float rstd = rsqrtf(ss * (1.f / 64.f) + EPS);
    const float* gh = P.in[I_GHG] + layer * 512 + head * 64 + 4 * h; const bf16_t* GHG = (const bf16_t*)(ws + O_GHG) + ob; bf16_t* OHG = (bf16_t*)(ws + O_OBR) + (size_t)2 * NTOK * 512 + ob;
#pragma unroll
    for (int q = 0; q < 8; ++q) { const int vo = (q >> 2) * 32 + 8 * (q & 3);
        const f32x4 gg = *(const f32x4*)(gh + vo); const u32x2 gt = *(const u32x2*)(GHG + vo);
        u32x2 w; w.x = pk2(tot[q][0] * rstd * gg[0] * bflo(gt.x), tot[q][1] * rstd * gg[1] * bfhi(gt.x)); w.y = pk2(tot[q][2] * rstd * gg[2] * bflo(gt.y), tot[q][3] * rstd * gg[3] * bfhi(gt.y));
        *(u32x2*)(OHG + vo) = w; }
}

DI void hgrn_scan(const Params& P, int layer, int gtid, int ngt) {
    unsigned char* ws = P.ws; OPAQUE_V(gtid); OPAQUE_S(ws);
    const float* SGRP = (const float*)(ws + O_SGRP); const float* DGRP = (const float*)(ws + O_DGRP); float* GST = (float*)(ws + O_GST);
#pragma unroll 4
    for (int e = gtid; e < 32 * 8 * 2 * 4096; e += ngt) {
        const int kv = e & 4095, dir = (e >> 12) & 1, head = (e >> 13) & 7, b = e >> 16, k = kv >> 6, v = kv & 63;
        const int kk = k & 31, hh = (kk >> 2) & 1, ii = (kk & 3) + 4 * (kk >> 3), el = ((((k >> 5) * 2 + (v >> 5)) * 16 + ii) * 64) + hh * 32 + (v & 31);
        const int jf = ((2 * b + (dir ? 1 : 0)) * 8 + head) * 2 + dir, jl = ((2 * b + (dir ? 0 : 1)) * 8 + head) * 2 + dir;
        P.out[(dir ? OUT_SB : OUT_SF) + ((size_t)(b * 2 + layer) * 8 + head) * 4096 + kv] = __expf(DGRP[jl * 64 + k]) * SGRP[(size_t)jf * 4096 + el] + SGRP[(size_t)jl * 4096 + el];
    }
    for (int e = gtid; e < 32 * 4096; e += ngt) {
        const int seq = e >> 12, el = e & 4095, ri = el >> 6, ln = el & 63, blk = ri >> 4, i = ri & 15;
        const int k = 32 * (blk >> 1) + crow16(i, ln >> 5), v = 32 * (blk & 1) + (ln & 31), b = seq >> 4, head = (seq >> 1) & 7, dir = seq & 1;
        float Gv = P.in[dir ? I_SB : I_SF][((size_t)(b * 2 + layer) * 8 + head) * 4096 + k * 64 + v];
        float dv[16], sv[16];
#pragma unroll
        for (int p = 0; p < 16; ++p) { const int gq = dir ? 15 - p : p, jq = ((64 + b * 16 + gq) * 8 + head) * 2 + dir; dv[p] = DGRP[jq * 64 + k]; sv[p] = SGRP[(size_t)jq * 4096 + el]; }
#pragma unroll
        for (int p = 0; p < 16; ++p) { const int gq = dir ? 15 - p : p, jq = ((64 + b * 16 + gq) * 8 + head) * 2 + dir; GST[(size_t)(jq - 1024) * 4096 + el] = Gv; Gv = __expf(dv[p]) * Gv + sv[p]; }
    }
}

__global__ void __launch_bounds__(512, 2) fwd_kernel(Params P) {
    extern __shared__ __attribute__((aligned(16))) unsigned char lds_raw[];
    LAS unsigned char* lds = (LAS unsigned char*)lds_raw;
    cg::grid_group grid = cg::this_grid();
    const int tid = threadIdx.x, wid = __builtin_amdgcn_readfirstlane(tid >> 6), lane = tid & 63, bid = blockIdx.x; constexpr int G = 256;
    const int gw = bid * 8 + wid, ngw = G * 8, gtid = bid * 512 + tid, ngt = G * 512;
    unsigned char* ws = P.ws;
    if (tid < 16) ((LAS unsigned*)(lds + LDS_BAR))[tid] = 0u;
    __syncthreads();
    (void)xcd_barrier_post((unsigned*)(ws + O_CTL), (volatile LAS unsigned*)(lds + LDS_BAR));
#define GRID_BAR() do { XcdBarrier b_; unsigned char* wb_ = P.ws; OPAQUE_S(wb_); b_.bar = (unsigned*)(wb_ + O_CTL); b_.x = xb_xcc_id(); b_.st = (volatile LAS unsigned*)(lds + LDS_BAR); xcd_barrier(b_); } while (0)

    for (int rep_ = 0; rep_ < REP_S0; ++rep_) {
#ifndef SKIP_S0
    for (int j = bid; j < 192; j += G) setup_gemv(P, lds, j, tid, wid, lane);
    setup_convert(P, gtid, ngt);
    setup_transposes(P, lds, gw, ngw, wid, lane);
#endif

    }
    grid.sync();

#ifndef SKIP_S1
#pragma unroll 1
    for (int l = 0; l < 2; ++l) {
        pg8::Gemm g{(const bf16_t*)(ws + O_CCKV) + (size_t)l * 1024 * 256, (const bf16_t*)(ws + O_WUKV) + (size_t)l * 1024 * 256, 1024, 1024, 256, 0, 0};
        pg8::StaticOrder S; S.init(1024, 1024, G, (bid + G - 16 * l) % G, 1);
        EpiKV E{ws, l, 1};
        pg8::gemm_phase<EpiKV, pg8::StaticOrder>(lds, g, S, E, wid);
    }
    prenorm_layer0(P, gw, ngw, lane);
#endif

    GRID_BAR();

#pragma unroll 1
    for (int l = 0; l < 2; ++l) {
        unsigned char* ws = P.ws; OPAQUE_S(ws);
#pragma unroll 1
        for (int rep_ = 0; rep_ < REP_L1; ++rep_) {
#ifndef SKIP_L1
        {   pg8::Gemm g{(const bf16_t*)(ws + O_H), (const bf16_t*)(ws + O_WIN) + (size_t)l * NPROJ * DM, NTOK, NPROJ, DM, 0, 0};
            pg8::StaticOrder S; S.init(NTOK, NPROJ, G, opq_s(bid), 1);
            EpiIn E{ws, P.out, l, P.in[I_LBF], P.in[I_LBB]};
            pg8::gemm_phase<EpiIn, pg8::StaticOrder>(lds, g, S, E, wid); }
#endif

        }
        GRID_BAR();

        ws = P.ws; OPAQUE_S(ws);
#pragma unroll 1
        for (int rep_ = 0; rep_ < REP_L2; ++rep_) {
#ifndef SKIP_UQ
        ws = P.ws; OPAQUE_S(ws);
        {   pg8::Gemm g{(const bf16_t*)(ws + O_CQ), (const bf16_t*)(ws + O_WUQ) + (size_t)l * 768 * 512, NTOK, 768, 512, 0, 0};
            pg8::StaticOrder S; S.init(NTOK, 768, G, opq_s(bid), 1);
            EpiUQ E{ws};
            pg8::gemm_phase<EpiUQ, pg8::StaticOrder>(lds, g, S, E, wid); }
#endif

#ifndef SKIP_KV
        ws = P.ws; OPAQUE_S(ws);
        {   pg8::Gemm g{(const bf16_t*)(ws + O_CKVB), (const bf16_t*)(ws + O_WUKVG) + (size_t)l * 1024 * 256, NTOK, 1024, 256, 0, 0};
            pg8::StaticOrder S; { const int b2 = opq_s(bid); S.init(NTOK, 1024, 112, b2 >= 144 ? b2 - 144 : 100000, 1); }
            EpiKV E{ws, l, 0};
            pg8::gemm_phase<EpiKV, pg8::StaticOrder>(lds, g, S, E, wid); }
        mla_finish(P, l, bid * 512 + wid * 64 + lane_id(), ngt);
#endif

#pragma unroll 1
        for (int rq_ = 0; rq_ < REP_NAP; ++rq_) {
#ifndef SKIP_NAP
        ws = P.ws; OPAQUE_S(ws);
        for (int u = opq_s(bid); u < 256; u += G) {
            const int b = u >> 3, head = u & 7; const size_t r0 = (size_t)b * 256;
            const AttnSeg sa{nullptr, nullptr, nullptr, 0, 0};
            const AttnSeg sb{(const bf16_t*)(ws + O_KA) + r0 * 512 + head * 64, nullptr, (const bf16_t*)(ws + O_VTA) + (size_t)(b * 8 + head) * 64 * 256, 256, 256};
            attn_unit<4, false, false>(lds, (const bf16_t*)(ws + O_QA) + r0 * 512 + head * 64, 512, sa, sb, (const bf16_t*)(ws + O_GNA) + r0 * 512 + head * 64,
                                       (bf16_t*)(ws + O_OBR) + r0 * 512 + head * 64, nullptr, nullptr, nullptr, 0, wid);
        }
#endif
        }


#pragma unroll 1
        for (int rq_ = 0; rq_ < REP_NAS; ++rq_) {
#ifndef SKIP_NAS
        ws = P.ws; OPAQUE_S(ws);
        for (int u = opq_s(bid); u < 256; u += G) {
            const int pair_ = (u & 7) * 2 + (u >> 7), bs = pair_ >> 3, head = pair_ & 7, grow0 = 2 * ((u >> 3) & 15);     const size_t rb = (size_t)NPR + (size_t)bs * 2048, r0 = rb + (size_t)grow0 * 64;
            const AttnSeg sa{(const bf16_t*)(ws + O_CKA) + (size_t)(l * 2 + bs) * 512 * 512 + head * 64, nullptr, (const bf16_t*)(ws + O_CVTA) + (size_t)((l * 2 + bs) * 8 + head) * 64 * 512, 512, 512};
            const AttnSeg sb{nullptr, nullptr, nullptr, 0, 0};
            attn_unit<4, true, true>(lds, (const bf16_t*)(ws + O_QA) + r0 * 512 + head * 64, 512, sa, sb, (const bf16_t*)(ws + O_GNA) + r0 * 512 + head * 64,
                                     (bf16_t*)(ws + O_OBR) + r0 * 512 + head * 64, (const bf16_t*)(ws + O_KA) + rb * 512 + head * 64,
                                     (const bf16_t*)(ws + O_VTA) + (size_t)4194304 + (size_t)(bs * 8 + head) * 64 * 2048, P.in[I_RPB] + (size_t)(l * 8 + head) * 15 * 31, grow0, wid);
        }
#endif
        }


#pragma unroll 1
        for (int rq_ = 0; rq_ < REP_H1; ++rq_) {
#ifndef SKIP_H1
        ws = P.ws; OPAQUE_S(ws);
        if (wid < 6) for (int j = wid * G + opq_s(bid); j < 1536; j += 6 * G) hgrn_pass1(ws, lds, j, wid, lane_id());
#endif
        }


        }
        GRID_BAR();

        ws = P.ws; OPAQUE_S(ws);
        hgrn_scan(P, l, bid * 512 + wid * 64 + lane_id(), ngt);
#pragma unroll 1
        for (int rep_ = 0; rep_ < REP_L3; ++rep_) {
#pragma unroll 1
        for (int rq_ = 0; rq_ < REP_MLAP; ++rq_) {
#ifndef SKIP_MLAP
        ws = P.ws; OPAQUE_S(ws);
        for (int u = opq_s(bid); u < 256; u += G) {
            const int b = u >> 3, head = u & 7; const size_t r0 = (size_t)b * 256;
            const AttnSeg sa{nullptr, nullptr, nullptr, 0, 0};
            const AttnSeg sb{(const bf16_t*)(ws + O_KNP) + r0 * 512 + head * 64, (const bf16_t*)(ws + O_KRP) + r0 * 32, (const bf16_t*)(ws + O_VTMP) + (size_t)(b * 8 + head) * 64 * 256, 256, 256};
            attn_unit<6, false, false>(lds, (const bf16_t*)(ws + O_QM) + r0 * 768 + head * 96, 768, sa, sb, (const bf16_t*)(ws + O_GMLA) + r0 * 512 + head * 64,
                                       (bf16_t*)(ws + O_OBR) + (size_t)NTOK * 512 + r0 * 512 + head * 64, nullptr, nullptr, nullptr, 0, wid);
        }
#endif
        }


#pragma unroll 1
        for (int rq_ = 0; rq_ < REP_MLAS; ++rq_) {
#ifndef SKIP_MLAS
        ws = P.ws; OPAQUE_S(ws);
        for (int u = opq_s(bid); u < 256; u += G) {
            const int pair_ = (u & 7) * 2 + (u >> 7), bs = pair_ >> 3, head = pair_ & 7, qb = (u >> 3) & 15;     const size_t r0 = (size_t)NPR + (size_t)bs * 2048 + (size_t)qb * 128;
            const AttnSeg sa{(const bf16_t*)(ws + O_KNS) + (size_t)(l * 2 + bs) * 2560 * 512 + head * 64, (const bf16_t*)(ws + O_KRS) + (size_t)(l * 2 + bs) * 2560 * 32,
                             (const bf16_t*)(ws + O_VTMS) + (size_t)((l * 2 + bs) * 8 + head) * 64 * 2560, 2560, 2560};
            const AttnSeg sb{nullptr, nullptr, nullptr, 0, 0};
            attn_unit<6, true, false>(lds, (const bf16_t*)(ws + O_QM) + r0 * 768 + head * 96, 768, sa, sb, (const bf16_t*)(ws + O_GMLA) + r0 * 512 + head * 64,
                                      (bf16_t*)(ws + O_OBR) + (size_t)NTOK * 512 + r0 * 512 + head * 64, nullptr, nullptr, nullptr, 0, wid);
        }
#endif
        }


        GRID_BAR();
#pragma unroll 1
        for (int rq_ = 0; rq_ < REP_H2; ++rq_) {
#ifndef SKIP_H2
        ws = P.ws; OPAQUE_S(ws);
        for (int j = wid * G + opq_s(bid); j < 3072; j += 8 * G) hgrn_pass2(P, l, j, lane_id());
#endif
        }


        }
        GRID_BAR();

        ws = P.ws; OPAQUE_S(ws);
        {   unsigned* cntl = (unsigned*)(ws + O_CNT) + (size_t)l * 48 * 64;
#pragma unroll 1
            for (int pass = 0; pass < 2; ++pass) {
                const int b2 = opq_s(bid);
                pg8::Gemm g{(const bf16_t*)(ws + O_OBR) + (pass ? (size_t)NPR * 512 : 0), (const bf16_t*)(ws + O_WBR) + (size_t)l * 3 * DM * 512, pass ? NSM : NPR, DM, 512, (size_t)NTOK * 512 * 2, (size_t)DM * 512 * 2};
                pg8::StaticOrder S; S.init(pass ? NSM : NPR, DM, pass ? 128 : G, pass ? (b2 < 128 ? b2 : 100000) : b2, 3);
                EpiMerge E{ws, pass ? 32 : 0, cntl};
                pg8::gemm_phase<EpiMerge, pg8::StaticOrder>(lds, g, S, E, wid);
            }
            {   const int b2 = opq_s(bid); const bool lat = b2 < 128;
                pg8::Gemm g{(const bf16_t*)(ws + O_MERGED) + (lat ? (size_t)NPR * DM : 0), (const bf16_t*)(ws + O_WOUT) + (size_t)l * DM * DM, lat ? NSM : NPR, DM, DM, 0, 0};
                pg8::CountedOrder S; S.init(lat ? NSM : NPR, DM, 128, lat ? b2 : b2 - 128, 1); S.ready = cntl; S.need = 64u; S.pm0 = lat ? 32 : 0; S.wid = wid;
                EpiOut E{ws, lat ? 32 : 0};
                pg8::gemm_phase<EpiOut, pg8::CountedOrder>(lds, g, S, E, wid);
            }
        }
        GRID_BAR();

#ifndef SKIP_L6
        postnorm_phase(P, l, bid * 8 + wid, ngw, lane_id());
#endif

        if (l == 0) GRID_BAR();
    }
}

extern "C" void kernel_launch(void* const* d_in, const int* in_sizes, int n_in, void* d_out, int out_size, void* d_ws, size_t ws_size, hipStream_t stream) {
    static int grid = 0;
    if (grid == 0) {
        if (n_in != 27 || (size_t)out_size != OUT_END || ws_size < WS_TOTAL) { fprintf(stderr, "kernel_launch: unexpected shapes: n_in %d out %d ws %zu (need %zu)\n", n_in, out_size, ws_size, (size_t)WS_TOTAL); grid = -1; return; }
        int dev = 0, cus = 0, per_cu = 0;
        if (hipGetDevice(&dev) != hipSuccess || hipDeviceGetAttribute(&cus, hipDeviceAttributeMultiprocessorCount, dev) != hipSuccess) { fprintf(stderr, "kernel_launch: device query failed\n"); grid = -1; return; }
        if (hipFuncSetAttribute((const void*)fwd_kernel, hipFuncAttributeMaxDynamicSharedMemorySize, LDS_BYTES) != hipSuccess) { fprintf(stderr, "kernel_launch: hipFuncSetAttribute failed\n"); grid = -1; return; }
        if (hipOccupancyMaxActiveBlocksPerMultiprocessor(&per_cu, (const void*)fwd_kernel, 512, LDS_BYTES) != hipSuccess || per_cu < 1) { fprintf(stderr, "kernel_launch: occupancy query says %d blocks per CU\n", per_cu); (void)hipGetLastError(); per_cu = 1; }
        grid = cus * 1;
        if (grid != 256) { fprintf(stderr, "kernel_launch: needs more than 128 CUs (got %d): layer 1's weight copy is made by workgroups 128.. of the grid\n", cus); grid = -1; return; }
    }
    if (grid < 0) return;
    if (hipMemsetAsync((unsigned char*)d_ws + O_CTL, 0, CTL_BYTES, stream) != hipSuccess) { fprintf(stderr, "kernel_launch: memset of the barrier words failed\n"); return; }
    Params p{};
    for (int i = 0; i < 27; ++i) p.in[i] = (const float*)d_in[i];
    p.out = (float*)d_out; p.ws = (unsigned char*)d_ws;
    void* args[] = {&p};
    hipError_t e = hipLaunchCooperativeKernel((const void*)fwd_kernel, dim3(grid), dim3(512), args, LDS_BYTES, stream);
    if (e != hipSuccess) fprintf(stderr, "kernel_launch: cooperative launch failed: %s (grid %d)\n", hipGetErrorString(e), grid);
}
```
